# Optimizing an MI355X kernel written in HIP

```python
import math
import jax, jax.numpy as jnp
from jax import lax
import numpy as np

D_MODEL = 2048
BATCH = 8
SEQ = 4096
DEPTH = 4

CHUNK = 64
Q_BLOCK = 128
N_BRANCH = 4
BRANCH_WIDTH = D_MODEL // 4
DIFF_HEADS = 4
DIFF_QK_DIM = BRANCH_WIDTH // (2 * DIFF_HEADS)
DIFF_V_DIM = BRANCH_WIDTH // DIFF_HEADS
GLA_HEADS = 4
GLA_DK = BRANCH_WIDTH // (2 * GLA_HEADS)
GLA_DV = BRANCH_WIDTH // GLA_HEADS
GLA_GATE_RANK = 16
GLA_GATE_NORM = 16.0
MLSTM_HEADS = 4
MLSTM_DH = BRANCH_WIDTH // MLSTM_HEADS
MLSTM_CONV = 4
CA_HEADS = 4
CA_DH = BRANCH_WIDTH // CA_HEADS
CA_LEFT_CHUNKS = 8
REL_CLIP = 2 * CHUNK
D_FF = 4 * D_MODEL
EPS = 1e-6
DIFF_COLS = 3 * BRANCH_WIDTH
GLA_COLS = 2 * GLA_HEADS * GLA_DK + BRANCH_WIDTH + GLA_GATE_RANK + BRANCH_WIDTH
MLSTM_COLS = 4 * BRANCH_WIDTH + 2 * MLSTM_HEADS
CA_COLS = 3 * BRANCH_WIDTH
N_IN = DIFF_COLS + GLA_COLS + MLSTM_COLS + CA_COLS

kernel_name = 'hybrid_gated_streaming_encoder'


def rms_norm(x, g):
    xf = x.astype(jnp.float32)
    y = xf * lax.rsqrt(jnp.mean(xf * xf, axis=-1, keepdims=True) + EPS)
    return (y * g.astype(jnp.float32)).astype(x.dtype)


def head_rms_norm(x, g):
    H, d = x.shape[-2], x.shape[-1]
    return rms_norm(x, g.reshape(H, d))


def alibi_slopes(n):
    return jnp.asarray([2.0 ** (-8.0 * (h + 1) / n) for h in range(n)], jnp.float32)


def causal_conv(x, w, b):
    K, C = w.shape
    y = lax.conv_general_dilated(x, w[:, None, :], window_strides=(1,), padding=[(K - 1, 0)],
                                 dimension_numbers=('NWC', 'WIO', 'NWC'), feature_group_count=C)
    return y + b


def diff_attention(u, lam, gain, layer_idx):
    B, T, _ = u.shape
    q, k, v = jnp.split(u, 3, axis=-1)
    q = q.reshape(B, T, DIFF_HEADS, 2, DIFF_QK_DIM)
    k = k.reshape(B, T, DIFF_HEADS, 2, DIFF_QK_DIM)
    v = v.reshape(B, T, DIFF_HEADS, DIFF_V_DIM)
    lam_init = 0.8 - 0.6 * math.exp(-0.3 * layer_idx)
    lf = lam.astype(jnp.float32)
    lam_full = jnp.exp(jnp.sum(lf[0] * lf[1])) - jnp.exp(jnp.sum(lf[2] * lf[3])) + lam_init
    slopes = alibi_slopes(DIFF_HEADS)[None, :, None, None, None]
    scale = DIFF_QK_DIM ** -0.5
    pos = jnp.arange(T)
    outs = []
    for blk in range(T // Q_BLOCK):
        q0, q1 = blk * Q_BLOCK, (blk + 1) * Q_BLOCK
        tq, tk = pos[q0:q1], pos[:q1]
        s = jnp.einsum('bqhmd,bkhmd->bhmqk', q[:, q0:q1], k[:, :q1]).astype(jnp.float32) * scale
        dist = jnp.abs(tq[:, None] - tk[None, :]).astype(jnp.float32)
        allowed = (tk[None, :] // CHUNK) <= (tq[:, None] // CHUNK)
        s = jnp.where(allowed, s - slopes * dist, -jnp.inf)
        p = jax.nn.softmax(s, axis=-1)
        a = p[:, :, 0] - lam_full * p[:, :, 1]
        outs.append(jnp.einsum('bhqk,bkhd->bqhd', a.astype(v.dtype), v[:, :q1]))
    o = jnp.concatenate(outs, axis=1)
    o = head_rms_norm(o, gain) * (1.0 - lam_init)
    return o.reshape(B, T, -1)


def gla(u, w_gate_up, b_gate, gain):
    B, T, _ = u.shape
    H, dk, dv, L = GLA_HEADS, GLA_DK, GLA_DV, CHUNK
    nc = T // L
    c1 = H * dk
    q, k, v, g_low, r = jnp.split(u, [c1, 2 * c1, 2 * c1 + BRANCH_WIDTH, 2 * c1 + BRANCH_WIDTH + GLA_GATE_RANK], axis=-1)
    log_a = jax.nn.log_sigmoid((g_low @ w_gate_up + b_gate).astype(jnp.float32)) / GLA_GATE_NORM
    log_a = log_a.reshape(B, nc, L, H, dk)
    q = q.reshape(B, nc, L, H, dk).astype(jnp.float32) * dk ** -0.5
    k = k.reshape(B, nc, L, H, dk).astype(jnp.float32)
    v = v.reshape(B, nc, L, H, dv).astype(jnp.float32)
    cum = jnp.cumsum(log_a, axis=2)
    total = cum[:, :, -1]
    q_dec = q * jnp.exp(cum)
    k_inv = k * jnp.exp(-cum)
    k_tail = k * jnp.exp(total[:, :, None] - cum)
    causal = jnp.tril(jnp.ones((L, L), dtype=bool))
    att = jnp.where(causal, jnp.einsum('bcthk,bcshk->bchts', q_dec, k_inv), 0.0)
    o_intra = jnp.einsum('bchts,bcshv->bcthv', att, v)
    dS = jnp.einsum('bcshk,bcshv->bchkv', k_tail, v)

    def step(S, inp):
        decay, inc = inp
        return jnp.exp(decay)[..., None] * S + inc, S

    S0 = jnp.zeros((B, H, dk, dv), jnp.float32)
    _, S_prev = lax.scan(step, S0, (jnp.moveaxis(total, 1, 0), jnp.moveaxis(dS, 1, 0)))
    S_prev = jnp.moveaxis(S_prev, 0, 1)
    o_inter = jnp.einsum('bcthk,bchkv->bcthv', q_dec, S_prev)
    o = (o_intra + o_inter).reshape(B, T, H, dv)
    o = head_rms_norm(o, gain).reshape(B, T, -1) * jax.nn.silu(r.astype(jnp.float32))
    return o.astype(u.dtype)


def mlstm(u, conv_w, conv_b, b_i, b_f, gain):
    B, T, _ = u.shape
    H, d, L, W = MLSTM_HEADS, MLSTM_DH, CHUNK, BRANCH_WIDTH
    nc = T // L
    qk, v, o_pre, i_pre, f_pre = jnp.split(u, [2 * W, 3 * W, 4 * W, 4 * W + H], axis=-1)
    qk = jax.nn.silu(causal_conv(qk, conv_w, conv_b))
    q, k = jnp.split(qk, 2, axis=-1)
    hm = lambda a: a.reshape(B, nc, L, H, d).astype(jnp.float32).transpose(0, 1, 3, 2, 4)
    q, k, v = hm(q), hm(k) * d ** -0.5, hm(v)
    log_i = jnp.swapaxes((i_pre.astype(jnp.float32) + b_i).reshape(B, nc, L, H), 2, 3)
    log_f = jnp.swapaxes(jax.nn.log_sigmoid(f_pre.astype(jnp.float32) + b_f).reshape(B, nc, L, H), 2, 3)
    bcum = jnp.cumsum(log_f, axis=-1)
    btot = bcum[..., -1]
    causal = jnp.tril(jnp.ones((L, L), dtype=bool))
    Dlog = jnp.where(causal, bcum[..., :, None] - bcum[..., None, :] + log_i[..., None, :], -jnp.inf)
    tail = btot[..., None] - bcum + log_i
    m_loc = jnp.max(tail, axis=-1)
    w_tail = jnp.exp(tail - m_loc[..., None])
    dC = jnp.einsum('bchs,bchsk,bchsv->bchkv', w_tail, k, v)
    dn = jnp.einsum('bchs,bchsk->bchk', w_tail, k)

    def step(carry, inp):
        C, n, m = carry
        g, ml, dCc, dnc = inp
        m_new = jnp.maximum(g + m, ml)
        a, bb = jnp.exp(g + m - m_new), jnp.exp(ml - m_new)
        C_new = a[..., None, None] * C + bb[..., None, None] * dCc
        n_new = a[..., None] * n + bb[..., None] * dnc
        return (C_new, n_new, m_new), (C, n, m)

    init = (jnp.zeros((B, H, d, d), jnp.float32), jnp.zeros((B, H, d), jnp.float32), jnp.zeros((B, H), jnp.float32))
    mv = lambda a: jnp.moveaxis(a, 1, 0)
    _, (C_prev, n_prev, m_prev) = lax.scan(step, init, (mv(btot), mv(m_loc), mv(dC), mv(dn)))
    C_prev, n_prev, m_prev = jnp.moveaxis(C_prev, 0, 1), jnp.moveaxis(n_prev, 0, 1), jnp.moveaxis(m_prev, 0, 1)
    inter_log = bcum + m_prev[..., None]
    m_t = jnp.maximum(jnp.max(Dlog, axis=-1), inter_log)
    A = jnp.exp(Dlog - m_t[..., None]) * jnp.einsum('bchtk,bchsk->bchts', q, k)
    inter_w = jnp.exp(inter_log - m_t)
    num = jnp.einsum('bchts,bchsv->bchtv', A, v) + inter_w[..., None] * jnp.einsum('bchtk,bchkv->bchtv', q, C_prev)
    den = jnp.sum(A, axis=-1) + inter_w * jnp.einsum('bchtk,bchk->bcht', q, n_prev)
    h = num / jnp.maximum(jnp.abs(den), jnp.exp(-m_t))[..., None]
    h = h.transpose(0, 1, 3, 2, 4).reshape(B, T, H, d)
    o_gate = jax.nn.sigmoid(o_pre.astype(jnp.float32)).reshape(B, T, H, d)
    return head_rms_norm(o_gate * h, gain).reshape(B, T, -1).astype(u.dtype)


def chunk_band_attention(u, rel_table):
    B, T, _ = u.shape
    H, d, L = CA_HEADS, CA_DH, CHUNK
    nc, nb = T // L, CA_LEFT_CHUNKS + 1
    q, k, v = jnp.split(u, 3, axis=-1)
    q = q.reshape(B, nc, L, H, d)
    pad = ((0, 0), (CA_LEFT_CHUNKS, 0), (0, 0), (0, 0), (0, 0))
    kp = jnp.pad(k.reshape(B, nc, L, H, d), pad)
    vp = jnp.pad(v.reshape(B, nc, L, H, d), pad)
    band_idx = jnp.arange(nc)[:, None] + jnp.arange(nb)[None, :]
    kb = kp[:, band_idx].reshape(B, nc, nb * L, H, d)
    vb = vp[:, band_idx].reshape(B, nc, nb * L, H, d)
    s = jnp.einsum('bcqhd,bckhd->bchqk', q, kb).astype(jnp.float32) * d ** -0.5
    i = jnp.arange(L)
    j = jnp.arange(nb)
    key_off = ((nb - 1 - j)[:, None] * L - i[None, :]).reshape(-1)
    rel = i[:, None] + key_off[None, :]
    bias = rel_table[:, jnp.clip(rel, -REL_CLIP, REL_CLIP) + REL_CLIP].astype(jnp.float32)
    valid = jnp.repeat(band_idx >= CA_LEFT_CHUNKS, L, axis=1)
    s = jnp.where(valid[None, :, None, None, :], s + bias[None, None], -jnp.inf)
    p = jax.nn.softmax(s, axis=-1)
    o = jnp.einsum('bchqk,bckhd->bcqhd', p.astype(vb.dtype), vb)
    return o.reshape(B, T, H * d)


def setup_inputs(seed: int = 0) -> dict:
    key = jax.random.key(seed)
    ks = jax.random.split(key, 24)
    f32 = jnp.float32
    nrm = lambda k, shape, scale: scale * jax.random.normal(k, shape, f32)
    gain = lambda k, shape: 1.0 + 0.05 * jax.random.normal(k, shape, f32)
    L, D, W = DEPTH, D_MODEL, BRANCH_WIDTH
    return {
        'x': nrm(ks[0], (BATCH, SEQ, D), 1.0),
        'norm_mix_pre': gain(ks[1], (L, D)),
        'norm_mix_post': gain(ks[2], (L, D)),
        'w_in': nrm(ks[3], (L, D, N_IN), D ** -0.5),
        'diff_lambda': nrm(ks[4], (L, 4, DIFF_QK_DIM), 0.1),
        'diff_norm': gain(ks[5], (L, W)),
        'gla_w_gate_up': nrm(ks[6], (L, GLA_GATE_RANK, GLA_HEADS * GLA_DK), GLA_GATE_RANK ** -0.5),
        'gla_b_gate': nrm(ks[7], (L, GLA_HEADS * GLA_DK), 0.1),
        'gla_norm': gain(ks[8], (L, W)),
        'mlstm_conv_w': nrm(ks[9], (L, MLSTM_CONV, 2 * W), MLSTM_CONV ** -0.5),
        'mlstm_conv_b': nrm(ks[10], (L, 2 * W), 0.01),
        'mlstm_b_i': nrm(ks[11], (L, MLSTM_HEADS), 0.1),
        'mlstm_b_f': jnp.linspace(3.0, 6.0, MLSTM_HEADS, dtype=f32)[None, :] + nrm(ks[12], (L, MLSTM_HEADS), 0.1),
        'mlstm_norm': gain(ks[13], (L, W)),
        'rel_bias': nrm(ks[14], (L, CA_HEADS, 2 * REL_CLIP + 1), 0.1),
        'w_branch': nrm(ks[15], (L, N_BRANCH, W, D), W ** -0.5),
        'w_gate': nrm(ks[16], (L, N_BRANCH, D, D), D ** -0.5),
        'b_gate': nrm(ks[17], (L, N_BRANCH, D), 0.01),
        'w_out': nrm(ks[18], (L, D, D), D ** -0.5),
        'norm_ffn_pre': gain(ks[19], (L, D)),
        'norm_ffn_post': gain(ks[20], (L, D)),
        'w_up': nrm(ks[21], (L, D, D_FF), D ** -0.5),
        'w_down': nrm(ks[22], (L, D_FF, D), D_FF ** -0.5),
    }


def reference(x, norm_mix_pre, norm_mix_post, w_in, diff_lambda, diff_norm, gla_w_gate_up, gla_b_gate,
              gla_norm, mlstm_conv_w, mlstm_conv_b, mlstm_b_i, mlstm_b_f, mlstm_norm, rel_bias, w_branch,
              w_gate, b_gate, w_out, norm_ffn_pre, norm_ffn_post, w_up, w_down):
    for l in range(DEPTH):
        h = rms_norm(x, norm_mix_pre[l])
        u = h @ w_in[l]
        u_a, u_b, u_c, u_d = jnp.split(u, [DIFF_COLS, DIFF_COLS + GLA_COLS, DIFF_COLS + GLA_COLS + MLSTM_COLS], axis=-1)
        branches = [
            diff_attention(u_a, diff_lambda[l], diff_norm[l], l),
            gla(u_b, gla_w_gate_up[l], gla_b_gate[l], gla_norm[l]),
            mlstm(u_c, mlstm_conv_w[l], mlstm_conv_b[l], mlstm_b_i[l], mlstm_b_f[l], mlstm_norm[l]),
            chunk_band_attention(u_d, rel_bias[l]),
        ]
        merged = None
        for bi in range(N_BRANCH):
            gate = jax.nn.sigmoid(h @ w_gate[l, bi] + b_gate[l, bi])
            term = gate * (branches[bi] @ w_branch[l, bi])
            merged = term if merged is None else merged + term
        x = x + rms_norm(merged @ w_out[l], norm_mix_post[l])
        h2 = rms_norm(x, norm_ffn_pre[l])
        f = jnp.square(jax.nn.relu(h2 @ w_up[l])) @ w_down[l]
        x = x + rms_norm(f, norm_ffn_post[l])
    return x
```

```cpp
#include <hip/hip_runtime.h>
#include <cstdio>
#include <cstdint>
#include <cmath>
#define LAS __attribute__((address_space(3)))
#define FEXP(x) __expf(x)
#define FEXP2(x) __builtin_amdgcn_exp2f(x)
#define FLOG(x) __logf(x)
#define FRSQRT(x) __builtin_amdgcn_rsqf(x)
#define FRCP(x) __builtin_amdgcn_rcpf(x)
#define LAUNDER(x) asm volatile("" : "+v"(x))
#define UNIFORM(x) __builtin_amdgcn_readfirstlane(x)
__device__ __forceinline__ int lane_id_asm() { int l; asm volatile("v_mbcnt_lo_u32_b32 %0, -1, 0\n\tv_mbcnt_hi_u32_b32 %0, -1, %0" : "=v"(l)); return l; }
#define LANE_ID() lane_id_asm()
#define WAVE_ID() (g_wave_id_sgpr)
#define CFENCE() asm volatile("" ::: "memory")
#define SCHED_BAR() __builtin_amdgcn_sched_barrier(0)
#define SETPRIO(x) __builtin_amdgcn_s_setprio(x)

typedef unsigned short bf16;
typedef short bf16x8 __attribute__((ext_vector_type(8)));
typedef short bf16x4 __attribute__((ext_vector_type(4)));
typedef float f32x4 __attribute__((ext_vector_type(4)));
typedef float f32x16 __attribute__((ext_vector_type(16)));
typedef unsigned u32x4 __attribute__((ext_vector_type(4)));
typedef unsigned u32x2 __attribute__((ext_vector_type(2)));

constexpr int NB = 8, T = 4096;
constexpr int M = NB * T, D = 2048, NCH = T / 64, DEPTH = 4, DFF = 8192, NIN = 6680;
constexpr int ULD = 4864;
constexpr int U_DQ = 0, U_DK = 512, U_GQ = 1024, U_GK = 1280, U_GR = 1536, U_MQ = 2048, U_MK = 2560, U_MO = 3072, U_CQ = 3584, U_CK = 4096, U_GL = 4608, U_MI = 4624, U_MF = 4628;
constexpr int V_D = 0, V_G = 512, V_M = 1024, V_C = 1536;

__device__ __forceinline__ float bf2f(unsigned b) { return __builtin_bit_cast(float, b << 16); }
typedef float f32x2n __attribute__((ext_vector_type(2)));
typedef __bf16 bf16x2n __attribute__((ext_vector_type(2)));
__device__ __forceinline__ unsigned pk2(float lo, float hi) { const f32x2n v = {lo, hi}; return __builtin_bit_cast(unsigned, __builtin_convertvector(v, bf16x2n)); }
__device__ __forceinline__ unsigned f2bf(float f) { return pk2(f, 0.f) & 0xffffu; }
__device__ __forceinline__ f32x16 mfma32(bf16x8 a, bf16x8 b, f32x16 c) {
    return __builtin_amdgcn_mfma_f32_32x32x16_bf16(a, b, c, 0, 0, 0);
}
struct MixArgs {
    const bf16* U; const bf16* VT; bf16* BR;
    const float* diff_lambda; const float* diff_norm; const float* gla_wgu; const float* gla_bg; const float* gla_norm;
    const float* conv_w; const float* conv_b; const float* b_i; const float* b_f; const float* ml_norm; const float* rel_bias;
    float* ST;
    float lam_init; int pad_;
};
constexpr int KP = 272, VP = 136, KT_BYTES = 64 * KP, STG = KT_BYTES + 128 * VP;
constexpr float LOG2E = 1.4426950408889634f;

__device__ __forceinline__ bf16x8 ldfrag(const LAS unsigned char* p) { return *(const LAS bf16x8*)p; }
__device__ __forceinline__ bf16x8 ldfrag2(const LAS unsigned char* p) { const bf16x4 a = *(const LAS bf16x4*)p, b = *(const LAS bf16x4*)(p + 16); return __builtin_shufflevector(a, b, 0, 1, 2, 3, 4, 5, 6, 7); }
__device__ __forceinline__ u32x2 pack4(float a, float b, float c, float d) { u32x2 w; w.x = pk2(a, b); w.y = pk2(c, d); return w; }
__device__ __forceinline__ bf16x8 pack8f(const f32x16& x, int s) { u32x4 w; w.x = pk2(x[8 * s], x[8 * s + 1]); w.y = pk2(x[8 * s + 2], x[8 * s + 3]); w.z = pk2(x[8 * s + 4], x[8 * s + 5]); w.w = pk2(x[8 * s + 6], x[8 * s + 7]); return __builtin_bit_cast(bf16x8, w); }
__device__ __forceinline__ float fsigmoid(float x) { return FRCP(1.0f + FEXP(-x)); }
__device__ __forceinline__ float flogsig(float x) { return fminf(x, 0.f) - FLOG(1.0f + FEXP(-fabsf(x))); }
__device__ __forceinline__ f32x16 zero16() { f32x16 z; for (int i = 0; i < 16; ++i) z[i] = 0.f; return z; }

struct StageRegs { u32x4 w[4]; };
__device__ __forceinline__ void stage_load_k(StageRegs& R, const bf16* kbase  , int tid) {
#pragma unroll
    for (int i = 0; i < 4; ++i) { const int c = tid + 512 * i; R.w[i] = *(const u32x4*)(kbase + (size_t)(c >> 4) * ULD + (c & 15) * 8); }
}
__device__ __forceinline__ void stage_load_v(StageRegs& R, const bf16* vbase  , int tid) {
#pragma unroll
    for (int i = 0; i < 4; ++i) { const int c = tid + 512 * i; R.w[i] = *(const u32x4*)(vbase + (size_t)(c >> 4) * M + (c & 15) * 8); }
}
__device__ __forceinline__ void stage_store_k(const StageRegs& R, LAS unsigned char* buf, int tid) {
#pragma unroll
    for (int i = 0; i < 4; ++i) { const int c = tid + 512 * i; const int krow = c >> 4; *(LAS u32x4*)(buf + (krow >> 6) * STG + (krow & 63) * KP + (c & 15) * 16) = R.w[i]; }
}
__device__ __forceinline__ void stage_store_v(const StageRegs& R, LAS unsigned char* buf, int tid) {
#pragma unroll
    for (int i = 0; i < 4; ++i) { const int c = tid + 512 * i; const int vt = (c >> 3) & 1;
        LAS unsigned char* vp = buf + vt * STG + KT_BYTES + (c >> 4) * VP + (c & 7) * 16; u32x2 lo, hi; lo.x = R.w[i].x; lo.y = R.w[i].y; hi.x = R.w[i].z; hi.y = R.w[i].w; *(LAS u32x2*)vp = lo; *(LAS u32x2*)(vp + 8) = hi; }
}
__device__ __forceinline__ float xhalf_max(float x) {
    const auto r = __builtin_amdgcn_permlane32_swap(__builtin_bit_cast(unsigned, x), __builtin_bit_cast(unsigned, x), false, false);
    return fmaxf(__builtin_bit_cast(float, r[0]), __builtin_bit_cast(float, r[1]));
}
__device__ __forceinline__ void softmax_x(f32x16 (&x)[2], float& m_run, float& l_run, f32x16 (&o)[4], bf16x8 (&pf)[2][2]) {
    float mx = x[0][0];
#pragma unroll
    for (int q = 0; q < 2; ++q)
#pragma unroll
        for (int i = 0; i < 16; ++i) mx = fmaxf(mx, x[q][i]);
    mx = xhalf_max(mx);
    const float m_new = fmaxf(m_run, mx), alpha = FEXP2(m_run - m_new);
    float ps = 0.f;
#pragma unroll
    for (int q = 0; q < 2; ++q) {
#pragma unroll
        for (int i = 0; i < 16; ++i) { x[q][i] = FEXP2(x[q][i] - m_new); ps += x[q][i]; }
        pf[q][0] = pack8f(x[q], 0); pf[q][1] = pack8f(x[q], 1);
    }
    l_run = l_run * alpha + ps; m_run = m_new;
#pragma unroll
    for (int dt = 0; dt < 4; ++dt)
#pragma unroll
        for (int i = 0; i < 16; ++i) o[dt][i] *= alpha;
}
__device__ __forceinline__ void pv_x(const bf16x8 (&pf)[2][2], f32x16 (&o)[4], const LAS unsigned char* tbuf  , int r, int hh) {
#pragma unroll
    for (int q = 0; q < 2; ++q) {
        const LAS unsigned char* vb = tbuf + KT_BYTES + (32 * q + 4 * hh) * 2;
        bf16x8 vf[4][2];
#pragma unroll
        for (int dt = 0; dt < 4; ++dt) { vf[dt][0] = ldfrag2(vb + (32 * dt + r) * VP); vf[dt][1] = ldfrag2(vb + (32 * dt + r) * VP + 32); }
        SCHED_BAR(); SETPRIO(1);
#pragma unroll
        for (int dt = 0; dt < 4; ++dt) { o[dt] = mfma32(vf[dt][0], pf[q][0], o[dt]); o[dt] = mfma32(vf[dt][1], pf[q][1], o[dt]); }
        SETPRIO(0); SCHED_BAR();
    }
}

__device__ __forceinline__ void diff_attn_job(LAS unsigned char* lds, const int wave_, const MixArgs& A, int b, int h, int qb) {
    int tid_j = wave_ * 64 + LANE_ID(); LAUNDER(tid_j);
    const int tid = tid_j, wave = UNIFORM(tid >> 6), lane = tid & 63;
    const int qg = wave >> 1, map = wave & 1;
    const int tq = 128 * qb + 32 * qg + (lane & 31);
    bf16x8 qf[4];
#pragma unroll
    for (int s = 0; s < 4; ++s) qf[s] = *(const bf16x8*)(A.U + ((size_t)b * T + tq) * ULD + U_DQ + h * 128 + map * 64 + 16 * s + 8 * (lane >> 5));
    const float c1 = 0.125f * LOG2E, c2 = LOG2E * (h == 0 ? 0.25f : h == 1 ? 0.0625f : h == 2 ? 0.015625f : 0.00390625f);
    const int npair = qb + 1;
    f32x16 o[4]; o[0] = zero16(); o[1] = zero16(); o[2] = zero16(); o[3] = zero16();
    float m_run = -1e30f, l_run = 0.f;
    const bf16* kb0 = A.U + (size_t)b * T * ULD + U_DK + h * 128; const bf16* vb0 = A.VT + (size_t)(V_D + h * 128) * M + (size_t)b * T;
    StageRegs Rk, Rv;
    stage_load_k(Rk, kb0, tid); stage_load_v(Rv, vb0, tid);
    for (int p = 0; p < npair; ++p) {
        int lane_ = lane, tid_ = tid; LAUNDER(lane_); LAUNDER(tid_);
        const int r = lane_ & 31, hh = lane_ >> 5;
        LAS unsigned char* buf = lds + (p & 1) * 2 * STG;
        const bool more = p + 1 < npair, diag = (p == npair - 1);
        stage_store_k(Rk, buf, tid_); stage_store_v(Rv, buf, tid_);
        __syncthreads();
        if (more) { stage_load_k(Rk, kb0 + (size_t)(128 * (p + 1)) * ULD, tid_); stage_load_v(Rv, vb0 + 128 * (p + 1), tid_); }
#pragma unroll
        for (int tt = 0; tt < 2; ++tt) {
            const LAS unsigned char* tb = buf + tt * STG;
            if (!(tt == 1 && diag && qg < 2)) {
                f32x16 x[2]; x[0] = zero16(); x[1] = zero16();
                { bf16x8 kf[4][2];
#pragma unroll
                  for (int s = 0; s < 4; ++s) { kf[s][0] = ldfrag(tb + r * KP + map * 128 + s * 32 + hh * 16); kf[s][1] = ldfrag(tb + (32 + r) * KP + map * 128 + s * 32 + hh * 16); }
                  SCHED_BAR(); SETPRIO(1);
#pragma unroll
                  for (int s = 0; s < 4; ++s) { x[0] = mfma32(kf[s][0], qf[s], x[0]); x[1] = mfma32(kf[s][1], qf[s], x[1]); }
                  SETPRIO(0); SCHED_BAR(); }
                if (!diag) {
                    float c2l = c2; LAUNDER(c2l);
                    const float base = -c2l * (float)(tq - 128 * p - 64 * tt - 4 * hh), te1 = c2l, te2 = 2.f * c2l, te3 = 3.f * c2l;
#pragma unroll
                    for (int q = 0; q < 2; ++q)
#pragma unroll
                        for (int g = 0; g < 4; ++g) { const float bg = base + c2l * (float)(32 * q + 8 * g);
                            x[q][4 * g] = x[q][4 * g] * c1 + bg; x[q][4 * g + 1] = x[q][4 * g + 1] * c1 + (bg + te1); x[q][4 * g + 2] = x[q][4 * g + 2] * c1 + (bg + te2); x[q][4 * g + 3] = x[q][4 * g + 3] * c1 + (bg + te3); }
                } else {
                    const int dk0 = tq - (128 * p + 64 * tt + 4 * hh);
#pragma unroll
                    for (int q = 0; q < 2; ++q)
#pragma unroll
                        for (int i = 0; i < 16; ++i) x[q][i] = x[q][i] * c1 - c2 * fabsf((float)(dk0 - (32 * q + (i & 3) + 8 * (i >> 2))));
                }
                bf16x8 pf[2][2];
                softmax_x(x, m_run, l_run, o, pf);
                pv_x(pf, o, tb, r, hh);
            }
        }
    }
    __syncthreads();
    l_run += __shfl_xor(l_run, 32);
    const float inv_l = FRCP(l_run);
    LAS float* EX = (LAS float*)lds;
    int lane_e = lane; LAUNDER(lane_e);
    const int lane_x = lane_e;
    if (map == 1) {
#pragma unroll
        for (int dt = 0; dt < 4; ++dt)
#pragma unroll
            for (int i = 0; i < 16; ++i) EX[(qg * 64 + dt * 16 + i) * 64 + lane_x] = o[dt][i] * inv_l;
    }
    __syncthreads();
    if (map == 0) {
        const int hh = lane_x >> 5;
        float s01 = A.diff_lambda[lane_x] * A.diff_lambda[64 + lane_x], s23 = A.diff_lambda[128 + lane_x] * A.diff_lambda[192 + lane_x];
#pragma unroll
        for (int o_ = 1; o_ < 64; o_ <<= 1) { s01 += __shfl_xor(s01, o_); s23 += __shfl_xor(s23, o_); }
        const float lam_full = FEXP(s01) - FEXP(s23) + A.lam_init;
        float ss = 0.f;
#pragma unroll
        for (int dt = 0; dt < 4; ++dt)
#pragma unroll
            for (int i = 0; i < 16; ++i) { const float v = o[dt][i] * inv_l - lam_full * EX[(qg * 64 + dt * 16 + i) * 64 + lane_x]; o[dt][i] = v; ss += v * v; }
        ss += __shfl_xor(ss, 32);
        const float sc = FRSQRT(ss * (1.0f / 128.0f) + 1e-6f) * (1.0f - A.lam_init);
        bf16* orow = A.BR + ((size_t)b * T + 128 * qb + 32 * qg + (lane_x & 31)) * 2048 + h * 128;
#pragma unroll
        for (int dt = 0; dt < 4; ++dt)
#pragma unroll
            for (int g = 0; g < 4; ++g) { const int d = 32 * dt + 8 * g + 4 * hh; const f32x4 gn = *(const f32x4*)(A.diff_norm + h * 128 + d);
                *(u32x2*)(orow + d) = pack4(o[dt][4 * g] * sc * gn[0], o[dt][4 * g + 1] * sc * gn[1], o[dt][4 * g + 2] * sc * gn[2], o[dt][4 * g + 3] * sc * gn[3]); }
    }
    __syncthreads();
}

__device__ __forceinline__ void band_attn_job(LAS unsigned char* lds, const int wave_, const MixArgs& A, int b, int h, int cg) {
    int tid_j = wave_ * 64 + LANE_ID(); LAUNDER(tid_j);
    const int tid = tid_j, wave = UNIFORM(tid >> 6), lane = tid & 63;
    const int cq = 4 * cg + (wave >> 1), tq = 64 * cq + 32 * (wave & 1) + (lane & 31);
    LAS float* TAB = (LAS float*)(lds + 4 * STG);
    if (tid < 257) TAB[tid] = A.rel_bias[h * 257 + tid] * LOG2E;
    bf16x8 qf[8];
#pragma unroll
    for (int s = 0; s < 8; ++s) qf[s] = *(const bf16x8*)(A.U + ((size_t)b * T + tq) * ULD + U_CQ + h * 128 + 16 * s + 8 * (lane >> 5));
    const float c1 = 0.08838834764831845f * LOG2E;
    const int ck0 = (4 * cg - 8 > 0) ? 4 * cg - 8 : 0, npair = (4 * cg + 4 - ck0) >> 1;
    f32x16 o[4]; o[0] = zero16(); o[1] = zero16(); o[2] = zero16(); o[3] = zero16();
    float m_run = -1e30f, l_run = 0.f;
    const bf16* kb0 = A.U + ((size_t)b * T + 64 * ck0) * ULD + U_CK + h * 128; const bf16* vb0 = A.VT + (size_t)(V_C + h * 128) * M + (size_t)b * T + 64 * ck0;
    StageRegs Rk, Rv;
    stage_load_k(Rk, kb0, tid); stage_load_v(Rv, vb0, tid);
    for (int p = 0; p < npair; ++p) {
        int lane_ = lane, tid_ = tid; LAUNDER(lane_); LAUNDER(tid_);
        const int r = lane_ & 31, hh = lane_ >> 5;
        LAS unsigned char* buf = lds + (p & 1) * 2 * STG;
        const bool more = p + 1 < npair;
        stage_store_k(Rk, buf, tid_); stage_store_v(Rv, buf, tid_);
        __syncthreads();
        if (more) { stage_load_k(Rk, kb0 + (size_t)(128 * (p + 1)) * ULD, tid_); stage_load_v(Rv, vb0 + 128 * (p + 1), tid_); }
#pragma unroll
        for (int tt = 0; tt < 2; ++tt) {
            const LAS unsigned char* tb = buf + tt * STG;
            const int ck = ck0 + 2 * p + tt; const bool act = (ck <= cq && ck >= cq - 8);
            f32x16 x[2]; bf16x8 pf[2][2];
            if (act) {
                x[0] = zero16(); x[1] = zero16();
#pragma unroll
                for (int sh = 0; sh < 2; ++sh) { bf16x8 kf[4][2];
#pragma unroll
                  for (int s = 0; s < 4; ++s) { kf[s][0] = ldfrag(tb + r * KP + (4 * sh + s) * 32 + hh * 16); kf[s][1] = ldfrag(tb + (32 + r) * KP + (4 * sh + s) * 32 + hh * 16); }
                  SCHED_BAR(); SETPRIO(1);
#pragma unroll
                  for (int s = 0; s < 4; ++s) { x[0] = mfma32(kf[s][0], qf[4 * sh + s], x[0]); x[1] = mfma32(kf[s][1], qf[4 * sh + s], x[1]); }
                  SETPRIO(0); SCHED_BAR(); }
                if (cq - ck >= 3) {
                    const float bias = TAB[256];
#pragma unroll
                    for (int q = 0; q < 2; ++q)
#pragma unroll
                        for (int i = 0; i < 16; ++i) x[q][i] = x[q][i] * c1 + bias;
                } else {
                    const int dk0 = tq - (64 * ck + 4 * hh);
#pragma unroll
                    for (int q = 0; q < 2; ++q)
#pragma unroll
                        for (int i = 0; i < 16; ++i) { int rel = dk0 - (32 * q + (i & 3) + 8 * (i >> 2)); rel = rel < -128 ? -128 : (rel > 128 ? 128 : rel); x[q][i] = x[q][i] * c1 + TAB[rel + 128]; }
                }
                softmax_x(x, m_run, l_run, o, pf);
            }
            if (act) pv_x(pf, o, tb, r, hh);
        }
    }
    l_run += __shfl_xor(l_run, 32);
    int lane_e = lane; LAUNDER(lane_e);
    const float inv_l = FRCP(l_run); const int hh = lane_e >> 5;
    bf16* orow = A.BR + ((size_t)b * T + 64 * cq + 32 * (wave & 1) + (lane_e & 31)) * 2048 + 3 * 512 + h * 128;
#pragma unroll
    for (int dt = 0; dt < 4; ++dt)
#pragma unroll
        for (int g = 0; g < 4; ++g) { const int d = 32 * dt + 8 * g + 4 * hh;
            *(u32x2*)(orow + d) = pack4(o[dt][4 * g] * inv_l, o[dt][4 * g + 1] * inv_l, o[dt][4 * g + 2] * inv_l, o[dt][4 * g + 3] * inv_l); }
    __syncthreads();
}

constexpr int GP = 144;
constexpr int G_QR = 0, G_KR = 8192, G_GL = 16384, G_WGU = 18432, G_BG = 22528, G_SEG = 22784, G_ETOT = 24832, G_QD = 25088, G_KI = G_QD + 64 * GP, G_KTT = G_KI + 64 * GP,
              G_VTI = G_KTT + 64 * GP, G_STI = G_VTI + 128 * GP, G_ATT = G_STI + 128 * GP, G_SSQ = G_ATT + 64 * GP, G_GAIN = G_SSQ + 1024, G_END = G_GAIN + 512;
struct GlaRegs { u32x4 q, k, gl, v[2]; };
__device__ __forceinline__ void gla_load(GlaRegs& R, const MixArgs& A, int b, int h, int c, int tid) {
    const size_t m0 = (size_t)b * T + 64 * c;
    R.q = *(const u32x4*)(A.U + (m0 + (tid >> 3)) * ULD + U_GQ + h * 64 + (tid & 7) * 8);
    R.k = *(const u32x4*)(A.U + (m0 + (tid >> 3)) * ULD + U_GK + h * 64 + (tid & 7) * 8);
    if (tid < 128) R.gl = *(const u32x4*)(A.U + (m0 + (tid >> 1)) * ULD + U_GL + (tid & 1) * 8);
#pragma unroll
    for (int i = 0; i < 2; ++i) { const int cc = tid + 512 * i; R.v[i] = *(const u32x4*)(A.VT + (size_t)(V_G + h * 128 + (cc >> 3)) * M + m0 + (cc & 7) * 8); }
}
constexpr int NSEG = 4, CPS = NCH / NSEG, NBH = NB * 4;
constexpr int GST = 8192 + 64, MST = 16384 + 128 + 4 + 124;
__device__ __forceinline__ float* gla_slot(const MixArgs& A, int bh, int sg) { return A.ST + (size_t)(bh * NSEG + sg) * GST; }
__device__ __forceinline__ float* ml_slot(const MixArgs& A, int bh, int sg) { return A.ST + (size_t)NBH * NSEG * GST + (size_t)(bh * NSEG + sg) * MST; }
__device__ __forceinline__ void gla_job(LAS unsigned char* lds, const int wave_, const MixArgs& A, int b, int h, int sg, int mode) {
    int tid_j = wave_ * 64 + LANE_ID(); LAUNDER(tid_j);
    const int tid0 = tid_j, wave = UNIFORM(tid0 >> 6), lane0 = tid0 & 63;
    const int seg = wave;
    const int ki = wave >> 2, ni = wave & 3;
    LAS float* WGU = (LAS float*)(lds + G_WGU); LAS float* BG = (LAS float*)(lds + G_BG); LAS float* SEG = (LAS float*)(lds + G_SEG); LAS float* ETOT = (LAS float*)(lds + G_ETOT);
    LAS float* SSQ = (LAS float*)(lds + G_SSQ); LAS float* GAIN = (LAS float*)(lds + G_GAIN);
    for (int i = tid0; i < 1024; i += 512) WGU[i] = A.gla_wgu[(i >> 6) * 256 + h * 64 + (i & 63)];
    if (tid0 < 64) BG[tid0] = A.gla_bg[h * 64 + tid0];
    if (tid0 < 128) GAIN[tid0] = A.gla_norm[h * 128 + tid0];
    f32x16 S = zero16();
    const int c0 = sg * CPS, c1 = c0 + CPS;
    float dseg = 1.f;
    const bool outs = (mode != 1), keep = (mode != 3);
    if (mode == 3) {
        for (int sp = 0; sp < sg; ++sp) {
            int lane = lane0; LAUNDER(lane); const int hh = lane >> 5;
            const float* slot = gla_slot(A, b * 4 + h, sp);
            __syncthreads();
            if (tid0 < 64) ETOT[tid0] = slot[8192 + tid0];
            __syncthreads();
#pragma unroll
            for (int g = 0; g < 4; ++g) { const f32x4 e = *(const LAS f32x4*)(ETOT + 32 * ki + 8 * g + 4 * hh); S[4 * g] *= e[0]; S[4 * g + 1] *= e[1]; S[4 * g + 2] *= e[2]; S[4 * g + 3] *= e[3]; }
#pragma unroll
            for (int i = 0; i < 16; ++i) S[i] += slot[(wave * 16 + i) * 64 + lane];
        }
        __syncthreads();
    }
    GlaRegs R; gla_load(R, A, b, h, c0, tid0);
    for (int c = c0; c < c1; ++c) {
        int lane = lane0, tid = tid0; LAUNDER(lane); LAUNDER(tid);
        const int r = lane & 31, hh = lane >> 5, j = lane;
        *(LAS u32x4*)(lds + G_QR + (tid >> 3) * 128 + (tid & 7) * 16) = R.q;
        *(LAS u32x4*)(lds + G_KR + (tid >> 3) * 128 + (tid & 7) * 16) = R.k;
        if (tid < 128) *(LAS u32x4*)(lds + G_GL + (tid >> 1) * 32 + (tid & 1) * 16) = R.gl;
#pragma unroll
        for (int i = 0; i < 2; ++i) { const int cc = tid + 512 * i; *(LAS u32x4*)(lds + G_VTI + (cc >> 3) * GP + (cc & 7) * 16) = R.v[i]; }
        __syncthreads();
        if (c + 1 < c1) gla_load(R, A, b, h, c + 1, tid);
        u32x2 rgate[4];
#pragma unroll
        for (int g = 0; g < 4; ++g) { rgate[g].x = 0u; rgate[g].y = 0u; if (outs) rgate[g] = *(const u32x2*)(A.U + ((size_t)b * T + 64 * c + 32 * ki + r) * ULD + U_GR + h * 128 + 32 * ni + 8 * g + 4 * hh); }
        float cl[8]; float run = 0.f;
#pragma unroll
        for (int tt = 0; tt < 8; ++tt) { const int t = 8 * seg + tt; float d = BG[j];
#pragma unroll
            for (int i = 0; i < 16; ++i) d += bf2f(((const LAS bf16*)(lds + G_GL))[t * 16 + i]) * WGU[i * 64 + j];
            run += flogsig(d) * (1.0f / 16.0f); cl[tt] = run; }
        SEG[seg * 64 + j] = run;
        __syncthreads();
        { float off = 0.f, tot = 0.f;
#pragma unroll
          for (int s2 = 0; s2 < 8; ++s2) { const float v = SEG[s2 * 64 + j]; tot += v; if (s2 < seg) off += v; }
          if (seg == 0) { const float et = FEXP(tot); ETOT[j] = et; dseg *= et; }
#pragma unroll
          for (int tt = 0; tt < 8; ++tt) { const int t = 8 * seg + tt; const float cum = cl[tt] + off;
              const float qv = bf2f(((const LAS bf16*)(lds + G_QR))[t * 64 + j]), kv = bf2f(((const LAS bf16*)(lds + G_KR))[t * 64 + j]);
              if (outs) { *(LAS bf16*)(lds + G_QD + t * GP + j * 2) = (bf16)f2bf(qv * 0.125f * FEXP(cum));
                               *(LAS bf16*)(lds + G_KI + t * GP + j * 2) = (bf16)f2bf(kv * FEXP(-cum)); }
              *(LAS bf16*)(lds + G_KTT + j * GP + t * 2) = (bf16)f2bf(kv * FEXP(tot - cum)); }
          if (outs) {
#pragma unroll
            for (int g = 0; g < 4; ++g) *(LAS u32x2*)(lds + G_STI + (32 * ni + r) * GP + (32 * ki + 8 * g + 4 * hh) * 2) = pack4(S[4 * g], S[4 * g + 1], S[4 * g + 2], S[4 * g + 3]); }
        }
        __syncthreads();
        {
#pragma unroll
            for (int g = 0; g < 4; ++g) { const f32x4 e = *(const LAS f32x4*)(ETOT + 32 * ki + 8 * g + 4 * hh); S[4 * g] *= e[0]; S[4 * g + 1] *= e[1]; S[4 * g + 2] *= e[2]; S[4 * g + 3] *= e[3]; }
#pragma unroll
            for (int s = 0; s < 4; ++s) S = mfma32(ldfrag(lds + G_KTT + (32 * ki + r) * GP + s * 32 + hh * 16), ldfrag(lds + G_VTI + (32 * ni + r) * GP + s * 32 + hh * 16), S);
            if (wave < 4 && outs) {
                const int si = wave >> 1, ti = wave & 1; f32x16 x = zero16();
                if (si <= ti) {
#pragma unroll
                    for (int s = 0; s < 4; ++s) x = mfma32(ldfrag(lds + G_KI + (32 * si + r) * GP + s * 32 + hh * 16), ldfrag(lds + G_QD + (32 * ti + r) * GP + s * 32 + hh * 16), x);
                }
                const int t = 32 * ti + r;
#pragma unroll
                for (int i = 0; i < 16; ++i) { const int s_ = 32 * si + (i & 3) + 8 * (i >> 2) + 4 * hh; if (s_ > t) x[i] = 0.f; }
#pragma unroll
                for (int g = 0; g < 4; ++g) *(LAS u32x2*)(lds + G_ATT + t * GP + (32 * si + 8 * g + 4 * hh) * 2) = pack4(x[4 * g], x[4 * g + 1], x[4 * g + 2], x[4 * g + 3]);
            }
        }
        __syncthreads();
        if (!outs) continue;
        const int ti = ki, t = 32 * ti + r;
        f32x16 o = zero16();
#pragma unroll
        for (int s = 0; s < 4; ++s) o = mfma32(ldfrag(lds + G_VTI + (32 * ni + r) * GP + s * 32 + hh * 16), ldfrag(lds + G_ATT + t * GP + s * 32 + hh * 16), o);
#pragma unroll
        for (int s = 0; s < 4; ++s) o = mfma32(ldfrag(lds + G_STI + (32 * ni + r) * GP + s * 32 + hh * 16), ldfrag(lds + G_QD + t * GP + s * 32 + hh * 16), o);
        { float ss = 0.f;
#pragma unroll
          for (int i = 0; i < 16; ++i) ss += o[i] * o[i];
          ss += __shfl_xor(ss, 32);
          if (hh == 0) SSQ[ni * 64 + t] = ss; }
        __syncthreads();
        { const float rstd = FRSQRT((SSQ[t] + SSQ[64 + t] + SSQ[128 + t] + SSQ[192 + t]) * (1.0f / 128.0f) + 1e-6f);
          const size_t mrow = (size_t)b * T + 64 * c + t;
#pragma unroll
          for (int g = 0; g < 4; ++g) { const int dv = 32 * ni + 8 * g + 4 * hh; const u32x2 rr = rgate[g];
              const float r0 = bf2f(rr.x & 0xffffu), r1 = bf2f(rr.x >> 16), r2 = bf2f(rr.y & 0xffffu), r3 = bf2f(rr.y >> 16);
              *(u32x2*)(A.BR + mrow * 2048 + 512 + h * 128 + dv) = pack4(o[4 * g] * rstd * GAIN[dv] * r0 * fsigmoid(r0), o[4 * g + 1] * rstd * GAIN[dv + 1] * r1 * fsigmoid(r1),
                                                                                   o[4 * g + 2] * rstd * GAIN[dv + 2] * r2 * fsigmoid(r2), o[4 * g + 3] * rstd * GAIN[dv + 3] * r3 * fsigmoid(r3)); }
        }
    }
    if (keep) {
        float* slot = gla_slot(A, b * 4 + h, sg);
#pragma unroll
        for (int i = 0; i < 16; ++i) slot[(wave * 16 + i) * 64 + lane0] = S[i];
        if (seg == 0) slot[8192 + lane0] = dseg;
    }
    __syncthreads();
}

constexpr int MP = 272;
constexpr int L_QR = 0, L_KR = 67 * MP, L_QI = 0, L_QW = 64 * MP, L_KI = 128 * MP, L_KWT = 192 * MP, L_VTI = L_KWT + 128 * GP, L_CTI = L_VTI + 128 * GP, L_AW = L_CTI + 128 * MP,
              L_SM = L_AW + 64 * GP;
constexpr int F_LI = 0, F_LF = 64, F_BC = 128, F_GG = 192, F_MT = 256, F_IW = 320, F_KW = 384, F_DEN = 448, F_QN = 576, F_SSQ = 640, F_NS = 896, F_CW = 1152, F_CB = 2176, F_GAIN = 2432, F_SC = 2560, F_END = 2576;
struct MlRegs { u32x4 q[3], k[3], v[2]; unsigned ip, fp; };
__device__ __forceinline__ void ml_load(MlRegs& R, const MixArgs& A, int b, int h, int c, int tid) {
    const size_t m0 = (size_t)b * T + 64 * c;
#pragma unroll
    for (int i = 0; i < 3; ++i) { const int cc = tid + 512 * i; const int row = cc >> 4, t = 64 * c + row - 3; unsigned z0 = 0u; LAUNDER(z0); u32x4 z; z.x = z.y = z.z = z.w = z0; R.q[i] = z; R.k[i] = z;
        if (row < 67 && t >= 0) { const bf16* p = A.U + ((size_t)b * T + t) * ULD + h * 128 + (cc & 15) * 8; R.q[i] = *(const u32x4*)(p + U_MQ); R.k[i] = *(const u32x4*)(p + U_MK); } }
#pragma unroll
    for (int i = 0; i < 2; ++i) { const int cc = tid + 512 * i; R.v[i] = *(const u32x4*)(A.VT + (size_t)(V_M + h * 128 + (cc >> 3)) * M + m0 + (cc & 7) * 8); }
    if (tid < 64) { R.ip = A.U[(m0 + tid) * ULD + U_MI + h]; R.fp = A.U[(m0 + tid) * ULD + U_MF + h]; }
}
__device__ __forceinline__ void mlstm_job(LAS unsigned char* lds, const int wave_, const MixArgs& A, int b, int h, int sg, int mode) {
    int tid_j = wave_ * 64 + LANE_ID(); LAUNDER(tid_j);
    const int tid0 = tid_j, wave = UNIFORM(tid0 >> 6), lane0 = tid0 & 63;
    const int ni = wave & 3, kq = wave >> 2;
    LAS float* F = (LAS float*)(lds + L_SM);
    for (int i = tid0; i < 1024; i += 512) { const int qk = i >> 9, jj = (i >> 7) & 3, d = i & 127; F[F_CW + i] = A.conv_w[jj * 1024 + qk * 512 + h * 128 + d]; }
    if (tid0 < 256) F[F_CB + tid0] = A.conv_b[(tid0 >> 7) * 512 + h * 128 + (tid0 & 127)];
    if (tid0 < 128) F[F_GAIN + tid0] = A.ml_norm[h * 128 + tid0];
    if (tid0 < 256) F[F_NS + tid0] = 0.f;
    const float bi = A.b_i[h], bfv = A.b_f[h];
    f32x16 C0 = zero16(), C1 = zero16();
    const bool outs = (mode != 1), keep = (mode != 3);
    float m_prev = (mode == 1) ? -1e30f : 0.f, gsum = 0.f;
    const int c0 = sg * CPS, c1 = c0 + CPS;
    if (mode == 3) {
        __syncthreads();
        for (int sp = 0; sp < sg; ++sp) {
            const float* slot = ml_slot(A, b * 4 + h, sp);
            const float mloc = slot[16384 + 128], G = slot[16384 + 129];
            const float m_out = fmaxf(G + m_prev, mloc), a = FEXP(G + m_prev - m_out), bsc = FEXP(mloc - m_out);
#pragma unroll
            for (int i = 0; i < 16; ++i) { C0[i] = a * C0[i] + bsc * slot[(wave * 32 + i) * 64 + lane0]; C1[i] = a * C1[i] + bsc * slot[(wave * 32 + 16 + i) * 64 + lane0]; }
            if (tid0 < 128) F[F_NS + tid0] = a * F[F_NS + tid0] + bsc * slot[16384 + tid0];
            m_prev = m_out;
        }
        __syncthreads();
    }
    MlRegs R; ml_load(R, A, b, h, c0, tid0);
    for (int c = c0; c < c1; ++c) {
        const int cur = c & 1, nxt = cur ^ 1;
        int lane = lane0, tid = tid0; LAUNDER(lane); LAUNDER(tid);
        const int r = lane & 31, hh = lane >> 5;
#pragma unroll
        for (int i = 0; i < 3; ++i) { const int cc = tid + 512 * i; const int row = cc >> 4; if (row < 67) { *(LAS u32x4*)(lds + L_QR + row * MP + (cc & 15) * 16) = R.q[i]; *(LAS u32x4*)(lds + L_KR + row * MP + (cc & 15) * 16) = R.k[i]; } }
#pragma unroll
        for (int i = 0; i < 2; ++i) { const int cc = tid + 512 * i; *(LAS u32x4*)(lds + L_VTI + (cc >> 3) * GP + (cc & 7) * 16) = R.v[i]; }
        if (tid < 64) { F[F_LI + tid] = bf2f(R.ip) + bi; F[F_LF + tid] = flogsig(bf2f(R.fp) + bfv); }
        __syncthreads();
        u32x2 ogate[4];
#pragma unroll
        for (int g = 0; g < 4; ++g) { ogate[g].x = 0u; ogate[g].y = 0u; if (outs) ogate[g] = *(const u32x2*)(A.U + ((size_t)b * T + 64 * c + 32 * kq + r) * ULD + U_MO + h * 128 + 32 * ni + 8 * g + 4 * hh); }
        if (wave == 0) {
            float bc = F[F_LF + lane];
#pragma unroll
            for (int d = 1; d < 64; d <<= 1) { const float v = __shfl_up(bc, d); if (lane >= d) bc += v; }
            const float btot = __shfl(bc, 63);
            const float li = F[F_LI + lane], g = li - bc;
            float pm = g;
#pragma unroll
            for (int d = 1; d < 64; d <<= 1) { const float v = __shfl_up(pm, d); if (lane >= d) pm = fmaxf(pm, v); }
            const float m_loc = btot + __shfl(pm, 63);
            const float mt = fmaxf(bc + pm, bc + m_prev), m_new = fmaxf(btot + m_prev, m_loc);
            F[F_BC + lane] = bc; F[F_GG + lane] = g; F[F_MT + lane] = mt; F[F_IW + lane] = FEXP(bc + m_prev - mt); F[F_KW + lane] = FEXP(btot + g - m_new);
            if (lane == 0) { F[F_SC] = m_new; F[F_SC + 1] = FEXP(btot + m_prev - m_new); }
            gsum += btot;
        }
        const int d8 = tid & 15, t2 = tid >> 4;
        float qv[2][8], kv[2][8];
#define ML_CONV(dst, RAW, CWO, CBO, SCL) do { \
    _Pragma("unroll") for (int u = 0; u < 2; ++u) _Pragma("unroll") for (int e = 0; e < 8; ++e) dst[u][e] = F[(CBO) + 8 * d8 + e]; \
    _Pragma("unroll") for (int jj = 0; jj < 4; ++jj) { float w8[8]; _Pragma("unroll") for (int e = 0; e < 8; ++e) w8[e] = F[(CWO) + jj * 128 + 8 * d8 + e]; \
        _Pragma("unroll") for (int u = 0; u < 2; ++u) { const u32x4 xx = *(const LAS u32x4*)(lds + (RAW) + (t2 + 32 * u + jj) * MP + d8 * 16); const unsigned xw[4] = {xx.x, xx.y, xx.z, xx.w}; \
            _Pragma("unroll") for (int e = 0; e < 8; ++e) dst[u][e] += w8[e] * bf2f((e & 1) ? (xw[e >> 1] >> 16) : (xw[e >> 1] & 0xffffu)); } } \
    _Pragma("unroll") for (int u = 0; u < 2; ++u) _Pragma("unroll") for (int e = 0; e < 8; ++e) dst[u][e] = dst[u][e] * fsigmoid(dst[u][e]) * (SCL); } while (0)
        if (outs) ML_CONV(qv, L_QR, F_CW, F_CB, 1.0f);
        CFENCE();
        ML_CONV(kv, L_KR, F_CW + 512, F_CB + 128, 0.08838834764831845f);
#undef ML_CONV
        __syncthreads();
        const float m_new = F[F_SC], adec = F[F_SC + 1];
#pragma unroll
        for (int u = 0; u < 2; ++u) { const int t = t2 + 32 * u; const float iw = F[F_IW + t], kw = F[F_KW + t];
            u32x4 w;
            if (outs) {
            w.x = pk2(qv[u][0], qv[u][1]); w.y = pk2(qv[u][2], qv[u][3]); w.z = pk2(qv[u][4], qv[u][5]); w.w = pk2(qv[u][6], qv[u][7]); *(LAS u32x4*)(lds + L_QI + t * MP + d8 * 16) = w;
            w.x = pk2(qv[u][0] * iw, qv[u][1] * iw); w.y = pk2(qv[u][2] * iw, qv[u][3] * iw); w.z = pk2(qv[u][4] * iw, qv[u][5] * iw); w.w = pk2(qv[u][6] * iw, qv[u][7] * iw); *(LAS u32x4*)(lds + L_QW + t * MP + d8 * 16) = w;
            w.x = pk2(kv[u][0], kv[u][1]); w.y = pk2(kv[u][2], kv[u][3]); w.z = pk2(kv[u][4], kv[u][5]); w.w = pk2(kv[u][6], kv[u][7]); *(LAS u32x4*)(lds + L_KI + t * MP + d8 * 16) = w;
            }
#pragma unroll
            for (int e = 0; e < 8; ++e) *(LAS bf16*)(lds + L_KWT + (8 * d8 + e) * GP + t * 2) = (bf16)f2bf(kv[u][e] * kw); }
#pragma unroll
        for (int g = 0; g < 4; ++g) { if (!outs) break;
            *(LAS u32x2*)(lds + L_CTI + (32 * ni + r) * MP + (64 * kq + 8 * g + 4 * hh) * 2) = pack4(C0[4 * g], C0[4 * g + 1], C0[4 * g + 2], C0[4 * g + 3]);
            *(LAS u32x2*)(lds + L_CTI + (32 * ni + r) * MP + (64 * kq + 32 + 8 * g + 4 * hh) * 2) = pack4(C1[4 * g], C1[4 * g + 1], C1[4 * g + 2], C1[4 * g + 3]); }
        __syncthreads();
#pragma unroll
        for (int i = 0; i < 16; ++i) { C0[i] *= adec; C1[i] *= adec; }
#pragma unroll
        for (int s = 0; s < 4; ++s) { const bf16x8 bv = ldfrag(lds + L_VTI + (32 * ni + r) * GP + s * 32 + hh * 16);
            C0 = mfma32(ldfrag(lds + L_KWT + (64 * kq + r) * GP + s * 32 + hh * 16), bv, C0); C1 = mfma32(ldfrag(lds + L_KWT + (64 * kq + 32 + r) * GP + s * 32 + hh * 16), bv, C1); if (s & 1) SCHED_BAR(); }
        if (wave < 4) { if (outs) {
            const int si = wave >> 1, ti = wave & 1, t = 32 * ti + r; f32x16 x = zero16();
            if (si <= ti) {
#pragma unroll
                for (int s = 0; s < 8; ++s) { x = mfma32(ldfrag(lds + L_KI + (32 * si + r) * MP + s * 32 + hh * 16), ldfrag(lds + L_QI + t * MP + s * 32 + hh * 16), x); if ((s & 3) == 3) SCHED_BAR(); }
            }
            const float bt = F[F_BC + t] - F[F_MT + t]; float dsum = 0.f;
#pragma unroll
            for (int g = 0; g < 4; ++g) { const f32x4 gg = *(const LAS f32x4*)(F + F_GG + 32 * si + 8 * g + 4 * hh);
#pragma unroll
                for (int e = 0; e < 4; ++e) { const int s_ = 32 * si + 8 * g + 4 * hh + e; const float wgt = (s_ <= t) ? FEXP(bt + gg[e]) : 0.f; x[4 * g + e] *= wgt; dsum += x[4 * g + e]; }
                *(LAS u32x2*)(lds + L_AW + t * GP + (32 * si + 8 * g + 4 * hh) * 2) = pack4(x[4 * g], x[4 * g + 1], x[4 * g + 2], x[4 * g + 3]); }
            dsum += __shfl_xor(dsum, 32);
            if (hh == 0) F[F_DEN + si * 64 + t] = dsum; }
        } else if (wave < 6) {
            const int d = tid - 256; float dn0 = 0.f, dn1 = 0.f;
#pragma unroll
            for (int c8 = 0; c8 < 8; ++c8) { const u32x4 w = *(const LAS u32x4*)(lds + L_KWT + d * GP + c8 * 16);
                dn0 += (bf2f(w.x & 0xffffu) + bf2f(w.x >> 16)) + (bf2f(w.y & 0xffffu) + bf2f(w.y >> 16)); dn1 += (bf2f(w.z & 0xffffu) + bf2f(w.z >> 16)) + (bf2f(w.w & 0xffffu) + bf2f(w.w >> 16)); }
            F[F_NS + nxt * 128 + d] = adec * F[F_NS + cur * 128 + d] + (dn0 + dn1);
        } else if (wave == 6 && outs) {
            const int t = tid - 384; float q0 = 0.f, q1 = 0.f;
#pragma unroll
            for (int c8 = 0; c8 < 16; ++c8) { const u32x4 w = *(const LAS u32x4*)(lds + L_QI + t * MP + c8 * 16);
                const f32x4 n0 = *(const LAS f32x4*)(F + F_NS + cur * 128 + 8 * c8), n1 = *(const LAS f32x4*)(F + F_NS + cur * 128 + 8 * c8 + 4);
                q0 += (bf2f(w.x & 0xffffu) * n0[0] + bf2f(w.x >> 16) * n0[1]) + (bf2f(w.y & 0xffffu) * n0[2] + bf2f(w.y >> 16) * n0[3]);
                q1 += (bf2f(w.z & 0xffffu) * n1[0] + bf2f(w.z >> 16) * n1[1]) + (bf2f(w.w & 0xffffu) * n1[2] + bf2f(w.w >> 16) * n1[3]); }
            F[F_QN + t] = q0 + q1;
        }
        __syncthreads();
        if (c + 1 < c1) ml_load(R, A, b, h, c + 1, tid);
        if (!outs) { m_prev = m_new; continue; }
        const int t = 32 * kq + r;
        f32x16 o = zero16();
#pragma unroll
        for (int s = 0; s < 4; ++s) o = mfma32(ldfrag(lds + L_VTI + (32 * ni + r) * GP + s * 32 + hh * 16), ldfrag(lds + L_AW + t * GP + s * 32 + hh * 16), o);
        SCHED_BAR();
#pragma unroll
        for (int s = 0; s < 8; ++s) { o = mfma32(ldfrag(lds + L_CTI + (32 * ni + r) * MP + s * 32 + hh * 16), ldfrag(lds + L_QW + t * MP + s * 32 + hh * 16), o); if ((s & 3) == 3) SCHED_BAR(); }
        const size_t mrow = (size_t)b * T + 64 * c + t;
        { const float den = F[F_DEN + t] + F[F_DEN + 64 + t] + F[F_IW + t] * F[F_QN + t];
          const float inv = FRCP(fmaxf(fabsf(den), FEXP(-F[F_MT + t]))); float ss = 0.f;
#pragma unroll
          for (int g = 0; g < 4; ++g) { const int dv = 32 * ni + 8 * g + 4 * hh; const u32x2 oo = ogate[g];
              const float g0 = fsigmoid(bf2f(oo.x & 0xffffu)), g1 = fsigmoid(bf2f(oo.x >> 16)), g2 = fsigmoid(bf2f(oo.y & 0xffffu)), g3 = fsigmoid(bf2f(oo.y >> 16));
              o[4 * g] *= inv * g0; o[4 * g + 1] *= inv * g1; o[4 * g + 2] *= inv * g2; o[4 * g + 3] *= inv * g3;
              ss += o[4 * g] * o[4 * g] + o[4 * g + 1] * o[4 * g + 1] + o[4 * g + 2] * o[4 * g + 2] + o[4 * g + 3] * o[4 * g + 3]; }
          ss += __shfl_xor(ss, 32);
          if (hh == 0) F[F_SSQ + ni * 64 + t] = ss; }
        __syncthreads();
        { const float rstd = FRSQRT((F[F_SSQ + t] + F[F_SSQ + 64 + t] + F[F_SSQ + 128 + t] + F[F_SSQ + 192 + t]) * (1.0f / 128.0f) + 1e-6f);
#pragma unroll
          for (int g = 0; g < 4; ++g) { const int dv = 32 * ni + 8 * g + 4 * hh;
              *(u32x2*)(A.BR + mrow * 2048 + 2 * 512 + h * 128 + dv) = pack4(o[4 * g] * rstd * F[F_GAIN + dv], o[4 * g + 1] * rstd * F[F_GAIN + dv + 1], o[4 * g + 2] * rstd * F[F_GAIN + dv + 2], o[4 * g + 3] * rstd * F[F_GAIN + dv + 3]); }
        }
        m_prev = m_new;
    }
    if (keep) {
        float* slot = ml_slot(A, b * 4 + h, sg);
#pragma unroll
        for (int i = 0; i < 16; ++i) { slot[(wave * 32 + i) * 64 + lane0] = C0[i]; slot[(wave * 32 + 16 + i) * 64 + lane0] = C1[i]; }
        if (tid0 < 128) slot[16384 + tid0] = F[F_NS + (c1 & 1) * 128 + tid0];
        if (tid0 == 0) { slot[16384 + 128] = m_prev; slot[16384 + 129] = (mode == 2) ? -1e30f : gsum; }
    }
    __syncthreads();
}

constexpr int NJ_SA = 2 * NBH * (NSEG - 1), NJ_SB = 2 * NBH * NSEG, NJ_DIFF = (T / 128) * NB * 4, NJ_BAND = (NCH / 4) * NB * 4;
constexpr int MIX_JOBWORD = 152 * 1024 - 64;
#ifndef JOB_MASK
#define JOB_MASK 15
#endif
#define MIX_LEADER() (WAVE_ID() == 0 && LANE_ID() == 0)
#define MIX_FIRST(CNT, JQ) do { __syncthreads();   if (MIX_LEADER()) *(volatile LAS unsigned*)(lds + MIX_JOBWORD) = atomicAdd((CNT), 1u); __syncthreads(); JQ = (int)*(volatile LAS unsigned*)(lds + MIX_JOBWORD); __syncthreads(); } while (0)
#define MIX_RANGE(CNT, JQ, START, END, BODY) while (JQ < (END)) { { const int job = JQ - (START); BODY; } \
        if (MIX_LEADER()) *(volatile LAS unsigned*)(lds + MIX_JOBWORD) = atomicAdd((CNT), 1u);     \
        __syncthreads(); JQ = (int)*(volatile LAS unsigned*)(lds + MIX_JOBWORD); }
constexpr int NJ_DIFF_A = ((T / 128) * 18 / 32) * NB * 4;
constexpr int JA0 = 0, JA1 = JA0 + NBH, JA2 = JA1 + NBH * (NSEG - 2), JA3 = JA2 + NBH, JA4 = JA3 + NBH * (NSEG - 2), JA5 = JA4 + NJ_DIFF_A, JA6 = JA5 + NJ_BAND;
constexpr int JB0 = 0, JB1 = JB0 + NBH * (NSEG - 1), JB2 = JB1 + NBH * (NSEG - 1), JB3 = JB2 + (NJ_DIFF - NJ_DIFF_A);
#ifndef PG8_ALIGN
#define PG8_ALIGN 1
#endif
#ifndef PG8_SP2
#define PG8_SP2 1
#endif
typedef int i32x4_t __attribute__((ext_vector_type(4)));
typedef int i32x8_t __attribute__((ext_vector_type(8)));
__device__ __forceinline__ unsigned pk4_fp8(float a, float b, float c, float d) {
    a = fminf(fmaxf(a, -448.f), 448.f); b = fminf(fmaxf(b, -448.f), 448.f); c = fminf(fmaxf(c, -448.f), 448.f); d = fminf(fmaxf(d, -448.f), 448.f);
    int w = __builtin_amdgcn_cvt_pk_fp8_f32(a, b, 0, false); w = __builtin_amdgcn_cvt_pk_fp8_f32(c, d, w, true); return (unsigned)w;
}
constexpr float NL2E = -1.4426950408889634f;
constexpr float F8_SC_HID = 4.f;
constexpr float F8_SC_H = 8.f, F8_SC_W = 512.f, F8_DESCALE = 1.f / (8.f * 512.f);
#ifndef PG8_FORCE8
#define PG8_FORCE8 0
#endif
namespace pg8 {
constexpr int BM = 256, BK = 64, HALF = 128, HTB = HALF * BK * 2, STAGE_BYTES = 8 * HTB, NXCD = 8, WGM = 8;
__host__ __device__ __forceinline__ int lds_byte(int r, int c) { const int st = (r >> 4) * 2 + (c >> 5), rr = r & 15, cc = c & 31, ob = rr * 64 + cc * 2; return st * 1024 + (ob ^ (((ob >> 9) & 1) << 5)); }
__host__ __device__ __forceinline__ void stage_rc(int b, int& R, int& C) { const int st = b / 1024, sb = b % 1024, swz = sb ^ (((sb >> 9) & 1) << 5); R = (st >> 1) * 16 + swz / 64; C = (st & 1) * 32 + (swz % 64) / 2; }
__host__ __device__ __forceinline__ int perm32(int rho) { const int n = rho >> 4, i = rho & 15; return 8 * (i >> 2) + 4 * n + (i & 3); }

struct Unit { const char* a; const char* b; int pm, pn, kind, nt; };

__device__ __forceinline__ void tile_of(int L, int nM, int nN, int& pm, int& pn) {
    const int nwg = nM * nN; int wgid = L; { const int q = nwg / NXCD, r = nwg % NXCD, xcd = wgid % NXCD, off = wgid / NXCD; wgid = (xcd < r ? xcd * (q + 1) : r * (q + 1) + (xcd - r) * q) + off; }
    const int wgm = nN <= 8 ? 4 : WGM;
    const int nig = wgm * nN, gid = wgid / nig, fm = gid * wgm, gsz = (nM - fm) < wgm ? (nM - fm) : wgm;
    pm = fm + ((wgid % nig) % gsz); pn = (wgid % nig) / gsz;
}

template <bool MIX8 = false, class Epi, class Sched>
__device__ __forceinline__ void gemm_phase(LAS unsigned char* lds, const int wave_, const int K  , const Sched& S, const Epi& E) {
    int tid_l = wave_ * 64 + LANE_ID(); LAUNDER(tid_l);
    const int tid = tid_l, wid = __builtin_amdgcn_readfirstlane(tid >> 6), lane = tid & 63, wr = wid >> 2, wc = wid & 3, fr = lane & 15, fq = lane >> 4;
    unsigned voffA[2], voffB[2];
#pragma unroll
    for (int i = 0; i < 2; ++i) { int R, C; stage_rc(tid * 16 + i * 8192, R, C); const int Rb = Epi::PERM ? ((R & ~31) + perm32(R & 31)) : R;
        voffA[i] = (unsigned)(R * K + C) * 2u; voffB[i] = (unsigned)(Rb * K + C) * 2u; }
    const size_t kstep = (size_t)(BK * 2);
    const size_t hstep = (size_t)HALF * K * 2;
    const unsigned ldsw = (unsigned)wid * 1024u;
    const int aoff = lds_byte(wr * 64 + fr, fq * 8), boff = lds_byte(wc * 32 + fr, fq * 8);
#define PG8_SA(b, h) (((b) * 2 + (h)) * HTB)
#define PG8_SB(b, h) ((4 + (b) * 2 + (h)) * HTB)
#define PG8_STAGE(bufoff, gbase, voff) do { _Pragma("unroll") for (int _i = 0; _i < 2; ++_i) \
        __builtin_amdgcn_global_load_lds((const unsigned*)((const char*)(gbase) + (voff)[_i]), (LAS unsigned*)(lds + (bufoff) + ldsw + _i * 8192), 16, 0, 0); } while (0)
#define PG8_LDA(dst, b, h) do { _Pragma("unroll") for (int m = 0; m < 4; ++m) _Pragma("unroll") for (int k = 0; k < 2; ++k) dst[m][k] = *(const LAS bf16x8*)(lds + PG8_SA(b, h) + aoff + m * 2048 + k * 1024); } while (0)
#define PG8_LDB(dst, b, h) do { _Pragma("unroll") for (int n = 0; n < 2; ++n) _Pragma("unroll") for (int k = 0; k < 2; ++k) dst[n][k] = *(const LAS bf16x8*)(lds + PG8_SB(b, h) + boff + n * 2048 + k * 1024); } while (0)
#define PG8_CAT8(x0, x1) __builtin_shufflevector(__builtin_bit_cast(i32x4_t, x0), __builtin_bit_cast(i32x4_t, x1), 0, 1, 2, 3, 4, 5, 6, 7)
#define PG8_MMA16(ai, bj, At, Bt) do { __builtin_amdgcn_s_setprio(1); _Pragma("unroll") for (int m = 0; m < 4; ++m) _Pragma("unroll") for (int n = 0; n < 2; ++n) _Pragma("unroll") for (int k = 0; k < 2; ++k) \
        acc[ai][bj][m][n] = __builtin_amdgcn_mfma_f32_16x16x32_bf16(Bt[n][k], At[m][k], acc[ai][bj][m][n], 0, 0, 0); __builtin_amdgcn_s_setprio(0); } while (0)
#define PG8_MMA8(ai, bj, At, Bt) do { __builtin_amdgcn_s_setprio(1); _Pragma("unroll") for (int m = 0; m < 4; ++m) _Pragma("unroll") for (int n = 0; n < 2; ++n) { \
        const i32x8_t _a = PG8_CAT8(Bt[n][0], Bt[n][1]), _b = PG8_CAT8(At[m][0], At[m][1]); \
        asm volatile("v_mfma_f32_16x16x128_f8f6f4 %0, %1, %2, %0" : "+v"(acc[ai][bj][m][n]) : "v"(_a), "v"(_b)); } __builtin_amdgcn_s_setprio(0); } while (0)
#define PG8_MFMA_DRAIN asm volatile("s_nop 15\n\ts_nop 15\n\ts_nop 7" ::: "memory")
#define PG8_WAIT_V(n) asm volatile("s_waitcnt vmcnt(" #n ")" ::: "memory")
#define PG8_WAIT_L(n) asm volatile("s_waitcnt lgkmcnt(" #n ")" ::: "memory")
#define PG8_BAR __builtin_amdgcn_s_barrier()
#define PG8_SCHED __builtin_amdgcn_sched_barrier(0)
    Unit cur, nxt; int ui = 0;
    if (!S.next(0, cur)) return;
    f32x4 acc[2][2][4][2];
    float z0 = 0.f; LAUNDER(z0);
#pragma unroll
    for (int a = 0; a < 2; ++a)
#pragma unroll
        for (int b = 0; b < 2; ++b)
#pragma unroll
            for (int m = 0; m < 4; ++m)
#pragma unroll
                for (int n = 0; n < 2; ++n) acc[a][b][m][n] = (f32x4){z0, z0, z0, z0};
    bf16x8 At[4][2], B0[2][2], B1[2][2];
    const char* cA = cur.a; const char* cB = cur.b;
    bool c8 = MIX8 && (cur.kind & 1);
    PG8_STAGE(PG8_SB(0, 0), cB, voffB); PG8_STAGE(PG8_SB(0, 1), cB + hstep, voffB); PG8_STAGE(PG8_SA(0, 0), cA, voffA); PG8_STAGE(PG8_SA(0, 1), cA + hstep, voffA);
    if (wr == 1) PG8_BAR;
    PG8_WAIT_V(2); PG8_BAR;
    PG8_STAGE(PG8_SB(1, 0), cB + kstep, voffB); PG8_STAGE(PG8_SA(1, 0), cA + kstep, voffA); PG8_STAGE(PG8_SB(1, 1), cB + hstep + kstep, voffB);
    PG8_WAIT_V(6); PG8_BAR;
    for (;;) {
        const bool has_next = S.next(ui + 1, nxt);
        const char* nA = has_next ? nxt.a : cA; const char* nB = has_next ? nxt.b : cB;
        const int nt = cur.nt;
        const bool n8 = MIX8 && ((has_next ? nxt.kind : cur.kind) & 1);
#define PG8_KLOOP(MMA) \
        for (int t = 0; t < nt; t += 2) { \
            const bool last = (t == nt - 2); \
            const char* a1 = cA + (size_t)(t + 1) * kstep; \
            const char* a2 = last ? nA : cA + (size_t)(t + 2) * kstep; const char* b2 = last ? nB : cB + (size_t)(t + 2) * kstep; \
            const char* a3 = a2 + kstep; const char* b3 = b2 + kstep; \
            PG8_LDB(B0, 0, 0); PG8_LDB(B1, 0, 1); PG8_SCHED; PG8_LDA(At, 0, 0); PG8_STAGE(PG8_SA(1, 1), a1 + hstep, voffA); \
            PG8_WAIT_V(8); PG8_WAIT_L(0); PG8_BAR; MMA(0, 0, At, B0); MMA(0, 1, At, B1); PG8_BAR; PG8_SCHED; \
            PG8_LDA(At, 0, 1); PG8_STAGE(PG8_SB(0, 0), b2, voffB); PG8_STAGE(PG8_SB(0, 1), b2 + hstep, voffB); PG8_STAGE(PG8_SA(0, 0), a2, voffA); \
            PG8_WAIT_V(8); PG8_WAIT_L(0); PG8_BAR; MMA(1, 0, At, B0); MMA(1, 1, At, B1); PG8_BAR; PG8_SCHED; \
            PG8_LDB(B0, 1, 0); PG8_LDB(B1, 1, 1); PG8_SCHED; PG8_LDA(At, 1, 0); PG8_STAGE(PG8_SA(0, 1), a2 + hstep, voffA); \
            PG8_WAIT_V(8); PG8_WAIT_L(0); PG8_BAR; MMA(0, 0, At, B0); MMA(0, 1, At, B1); PG8_BAR; PG8_SCHED; \
            PG8_LDA(At, 1, 1); PG8_STAGE(PG8_SB(1, 0), b3, voffB); PG8_STAGE(PG8_SB(1, 1), b3 + hstep, voffB); PG8_STAGE(PG8_SA(1, 0), a3, voffA); \
            PG8_WAIT_V(8); PG8_WAIT_L(0); PG8_BAR; MMA(1, 0, At, B0); MMA(1, 1, At, B1); PG8_BAR; PG8_SCHED; \
        }
        if (MIX8) { int c8l = __builtin_amdgcn_readfirstlane(c8 ? 1 : 0); asm volatile("" : "+s"(c8l));
            if (PG8_FORCE8 || c8l) { PG8_KLOOP(PG8_MMA8) PG8_MFMA_DRAIN; } else { PG8_KLOOP(PG8_MMA16) } }
        else { PG8_KLOOP(PG8_MMA16) }
#undef PG8_KLOOP
#if PG8_ALIGN
        if (wr == 0) PG8_BAR;
#endif
        if (MIX8) { int kl = __builtin_amdgcn_readfirstlane(cur.kind); asm volatile("" : "+s"(kl)); cur.kind = kl; }
        E(acc, cur, wr, wc, fr, fq);
        if (!has_next) break;
#pragma unroll
        for (int a = 0; a < 2; ++a)
#pragma unroll
            for (int b = 0; b < 2; ++b)
#pragma unroll
                for (int m = 0; m < 4; ++m)
#pragma unroll
                    for (int n = 0; n < 2; ++n) acc[a][b][m][n] = (f32x4){z0, z0, z0, z0};
        cur = nxt; cA = nA; cB = nB; ++ui; c8 = n8;
#if PG8_ALIGN
        if (wr == 1) PG8_BAR;
#endif
    }
    PG8_WAIT_V(0);
#if !PG8_ALIGN
    if (wr == 0) PG8_BAR;
#endif
    PG8_BAR;
#undef PG8_SA
#undef PG8_SB
#undef PG8_STAGE
#undef PG8_LDA
#undef PG8_LDB
#undef PG8_MMA16
#undef PG8_MMA8
#undef PG8_MFMA_DRAIN
#undef PG8_CAT8
#undef PG8_WAIT_V
#undef PG8_WAIT_L
#undef PG8_BAR
#undef PG8_SCHED
}

__device__ __forceinline__ unsigned cvt_pk_bf16(float lo, float hi) { return pk2(lo, hi); }

template <int ACT  , bool F8OUT = false  > struct EpiBf {
    static constexpr bool PERM = true;
    bf16* O0; int ld0; bf16* O1; int ld1;
    float osc;
    const float* rs;
    __device__ __forceinline__ void operator()(const f32x4 (&acc)[2][2][4][2], const Unit& u, int wr, int wc, int fr, int fq) const {
        bf16* base = u.kind ? O1 : O0; const int ldc = u.kind ? ld1 : ld0;
        int frl = fr, fql = fq; LAUNDER(frl); LAUNDER(fql);
        const int row0 = u.pm * BM + wr * 64 + frl, col0 = u.pn * BM + wc * 32 + 8 * fql;
        f32x4 cs[2][2];
        if (rs && u.kind) {
#pragma unroll
            for (int bj = 0; bj < 2; ++bj) { cs[bj][0] = *(const f32x4*)(rs + col0 + bj * HALF); cs[bj][1] = *(const f32x4*)(rs + col0 + bj * HALF + 4); } }
        float rrv[2][4];
#pragma unroll
        for (int ai = 0; ai < 2; ++ai)
#pragma unroll
            for (int m = 0; m < 4; ++m) rrv[ai][m] = (rs && !u.kind) ? rs[row0 + ai * HALF + m * 16] : osc;
#pragma unroll
        for (int ai = 0; ai < 2; ++ai)
#pragma unroll
            for (int m = 0; m < 4; ++m) { bf16* rowp = base + (size_t)(row0 + ai * HALF + m * 16) * ldc + col0;
                const float rr = rrv[ai][m];
#pragma unroll
                for (int bj = 0; bj < 2; ++bj) { f32x4 v0 = acc[ai][bj][m][0], v1 = acc[ai][bj][m][1];
                    if (rs && u.kind) { v0 = v0 * cs[bj][0]; v1 = v1 * cs[bj][1]; } else if (rs || osc != 1.f) { v0 = v0 * rr; v1 = v1 * rr; }
                    if (ACT == 1) {
#pragma unroll
                        for (int j = 0; j < 4; ++j) { const float a = fmaxf(v0[j], 0.f), b = fmaxf(v1[j], 0.f); v0[j] = a * a; v1[j] = b * b; } }
                    if (F8OUT) { u32x2 w8; w8.x = pk4_fp8(v0[0] * F8_SC_HID, v0[1] * F8_SC_HID, v0[2] * F8_SC_HID, v0[3] * F8_SC_HID); w8.y = pk4_fp8(v1[0] * F8_SC_HID, v1[1] * F8_SC_HID, v1[2] * F8_SC_HID, v1[3] * F8_SC_HID);
                        *(u32x2*)((unsigned char*)base + (size_t)(row0 + ai * HALF + m * 16) * ldc + col0 + bj * HALF) = w8; }
                    else { u32x4 w; w.x = cvt_pk_bf16(v0[0], v0[1]); w.y = cvt_pk_bf16(v0[2], v0[3]); w.z = cvt_pk_bf16(v1[0], v1[1]); w.w = cvt_pk_bf16(v1[2], v1[3]);
                    *(u32x4*)(rowp + bj * HALF) = w; } } }
    }
};
struct EpiF32 {
    static constexpr bool PERM = false;
    float* C; int ldc;
    __device__ __forceinline__ void operator()(const f32x4 (&acc)[2][2][4][2], const Unit& u, int wr, int wc, int fr, int fq) const {
        const int row0 = u.pm * BM + wr * 64 + fr, col0 = u.pn * BM + wc * 32 + 4 * fq;
#pragma unroll
        for (int ai = 0; ai < 2; ++ai)
#pragma unroll
            for (int m = 0; m < 4; ++m) { float* rowp = C + (size_t)(row0 + ai * HALF + m * 16) * ldc + col0;
#pragma unroll
                for (int bj = 0; bj < 2; ++bj)
#pragma unroll
                    for (int n = 0; n < 2; ++n) *(f32x4*)(rowp + bj * HALF + n * 16) = acc[ai][bj][m][n]; }
    }
};
struct EpiGateFused {
    static constexpr bool PERM = true;
    u32x4* PS; u32x4* MS; bf16* MG; const float* bias;
    __device__ __forceinline__ void operator()(const f32x4 (&acc)[2][2][4][2], const Unit& u, int wr, int wc, int fr, int fq) const {
        int frl = fr, fql = fq; LAUNDER(frl); LAUNDER(fql);
        const int bi = u.kind >> 1; const int lt = (wr * 4 + wc) * 64 + fql * 16 + frl;
        if (!(u.kind & 1)) {
#pragma unroll
            for (int ai = 0; ai < 2; ++ai)
#pragma unroll
                for (int m = 0; m < 4; ++m)
#pragma unroll
                    for (int bj = 0; bj < 2; ++bj) { const f32x4 v0 = acc[ai][bj][m][0], v1 = acc[ai][bj][m][1];
                        u32x4 w; w.x = cvt_pk_bf16(v0[0], v0[1]); w.y = cvt_pk_bf16(v0[2], v0[3]); w.z = cvt_pk_bf16(v1[0], v1[1]); w.w = cvt_pk_bf16(v1[2], v1[3]);
                        PS[((ai * 4 + m) * 2 + bj) * 512 + lt] = w; }
            return;
        }
        const int row0 = u.pm * BM + wr * 64 + frl, col0 = u.pn * BM + wc * 32 + 8 * fql;
        f32x4 bv[2][2];
#pragma unroll
        for (int bj = 0; bj < 2; ++bj)
#pragma unroll
            for (int n = 0; n < 2; ++n) bv[bj][n] = *(const f32x4*)(bias + bi * 2048 + col0 + bj * HALF + 4 * n) * NL2E;
        u32x4 pvv[2][2][2], ovv[2][2][2];
#define GF_LOAD(g) do { _Pragma("unroll") for (int ml = 0; ml < 2; ++ml) _Pragma("unroll") for (int bj = 0; bj < 2; ++bj) { const int si = (((g) * 2 + ml) * 2 + bj) * 512 + lt; \
            pvv[(g) & 1][ml][bj] = PS[si]; if (bi > 0) ovv[(g) & 1][ml][bj] = MS[si]; else ovv[(g) & 1][ml][bj] = pvv[(g) & 1][ml][bj]; } } while (0)
        GF_LOAD(0);
#pragma unroll
        for (int g = 0; g < 4; ++g) {
            const int ai = g >> 1, mh = g & 1;
            u32x4 wres[2][2];
#pragma unroll
            for (int ml = 0; ml < 2; ++ml)
#pragma unroll
                for (int bj = 0; bj < 2; ++bj) {
                    const int m = 2 * mh + ml;
                    const u32x4 pv = pvv[g & 1][ml][bj];
                    const f32x4 a0 = acc[ai][bj][m][0] * (F8_DESCALE * NL2E) + bv[bj][0], a1 = acc[ai][bj][m][1] * (F8_DESCALE * NL2E) + bv[bj][1];
                    f32x4 e0, e1;
#pragma unroll
                    for (int j = 0; j < 4; ++j) { e0[j] = __builtin_amdgcn_exp2f(a0[j]); e1[j] = __builtin_amdgcn_exp2f(a1[j]); }
                    const f32x4 d0 = e0 + 1.0f, d1 = e1 + 1.0f;
                    float v[8]; const unsigned pw[4] = {pv.x, pv.y, pv.z, pv.w};
#pragma unroll
                    for (int j = 0; j < 4; ++j) { v[j] = bf2f(j & 1 ? pw[j >> 1] >> 16 : pw[j >> 1] & 0xffffu) * FRCP(d0[j]); v[4 + j] = bf2f(j & 1 ? pw[2 + (j >> 1)] >> 16 : pw[2 + (j >> 1)] & 0xffffu) * FRCP(d1[j]); }
                    if (bi > 0) { const u32x4 ov = ovv[g & 1][ml][bj]; const unsigned ow[4] = {ov.x, ov.y, ov.z, ov.w};
#pragma unroll
                        for (int j = 0; j < 8; ++j) v[j] += bf2f(j & 1 ? ow[j >> 1] >> 16 : ow[j >> 1] & 0xffffu); }
                    u32x4 w; w.x = cvt_pk_bf16(v[0], v[1]); w.y = cvt_pk_bf16(v[2], v[3]); w.z = cvt_pk_bf16(v[4], v[5]); w.w = cvt_pk_bf16(v[6], v[7]);
                    wres[ml][bj] = w; }
            asm volatile("" ::: "memory");
            if (g == 0) GF_LOAD(1);
            if (g == 1) GF_LOAD(2);
            if (g == 2) GF_LOAD(3);
            asm volatile("" ::: "memory");
#pragma unroll
            for (int ml = 0; ml < 2; ++ml)
#pragma unroll
                for (int bj = 0; bj < 2; ++bj) { const int m = 2 * mh + ml; const int si = ((ai * 4 + m) * 2 + bj) * 512 + lt;
                    if (bi < 3) MS[si] = wres[ml][bj];
                    else *(u32x4*)(MG + (size_t)(row0 + ai * HALF + m * 16) * 2048 + col0 + bj * HALF) = wres[ml][bj]; }
            asm volatile("" ::: "memory");
        }
#undef GF_LOAD
    }
};

struct OrdPlain {
    const char* A; const char* B; size_t ta, tb, a_grp_stride; int nM, nN, a_grp_shift, G, c, nt, kind = 0;
    __device__ __forceinline__ bool next(int i, Unit& u) const {
        const long L = (long)i * G + c; if (L >= (long)nM * nN) return false;
        int pm, pn; tile_of((int)L, nM, nN, pm, pn); u.pm = pm; u.pn = pn; u.kind = kind; u.nt = nt;
        u.a = A + (size_t)pm * ta + (size_t)(pn >> a_grp_shift) * a_grp_stride; u.b = B + (size_t)pn * tb; return true;
    }
};
struct OrdInProj {
    const char* Hb; const char* Wb; size_t th; int G, c;
    __device__ __forceinline__ bool next(int i, Unit& u) const {
        const long L = (long)i * G + c; if (L >= 128L * 27) return false;
        int pm, pn; tile_of((int)L, 128, 27, pm, pn); u.nt = 32;
        if (pn < 19) { u.pm = pm; u.pn = pn; u.kind = 0; u.a = Hb + (size_t)pm * th; u.b = Wb + (size_t)pn * th; }
        else { u.pm = pn - 19; u.pn = pm; u.kind = 1; u.a = Wb + (size_t)pn * th; u.b = Hb + (size_t)pm * th; }
        return true;
    }
};
struct OrdGateFused {
    const char* Hb; const char* Wg; const char* BRb; const char* Wb; int G, c;
    __device__ __forceinline__ bool next(int i, Unit& u) const {
        const long L = (long)(i >> 3) * G + c; if (L >= 128L * 8) return false;
        int pm, pn; tile_of((int)L, 128, 8, pm, pn); const int bi = (i >> 1) & 3, isG = i & 1; const size_t th = (size_t)256 * 2048 * 2;
        u.pm = pm; u.pn = pn; u.kind = 2 * bi + isG;
        if (isG) { u.nt = 16; u.a = Hb + (size_t)pm * th; u.b = Wg + (size_t)(bi * 8 + pn) * th; }
        else { u.nt = 8; u.a = BRb + (size_t)pm * th + (size_t)bi * 1024; u.b = Wb + (size_t)pn * th + (size_t)bi * 1024; }
        return true;
    }
};
}
constexpr size_t MiB = 1u << 20;
constexpr size_t WS_CTL = 0, CTL_ZERO_BYTES = 1 * MiB;
constexpr size_t WS_WIN = 2 * MiB, WS_WG = 29 * MiB, WS_WB = 61 * MiB, WS_WO = 69 * MiB, WS_WUP = 77 * MiB, WS_WDN = 109 * MiB;
constexpr size_t WS_H = 142 * MiB;
constexpr size_t WS_BR = 270 * MiB;
constexpr size_t WS_U = 398 * MiB;
constexpr size_t WS_VT = 702 * MiB;
constexpr size_t WS_P = 398 * MiB;
constexpr size_t WS_Y = 398 * MiB;
constexpr size_t WS_HID = 398 * MiB;
constexpr size_t WS_MG = 910 * MiB;
constexpr size_t WS_Y2 = 910 * MiB;
constexpr size_t WS_H8 = 1038 * MiB;
constexpr size_t WS_XB = 1166 * MiB;
constexpr size_t WS_END = 1294 * MiB;
static_assert(WS_U + (size_t)M * ULD * 2 <= WS_VT && WS_VT + (size_t)2048 * M * 2 <= WS_MG && WS_P + (size_t)M * 8192 * 2 <= WS_MG && WS_Y2 + (size_t)M * 2048 * 4 <= WS_XB && WS_XB + (size_t)M * 2048 * 2 <= WS_END, "ws map");
static_assert(WS_WIN + (size_t)6912 * 2048 * 2 <= WS_WG && WS_WDN + (size_t)2048 * 8192 * 2 <= WS_H && WS_H + (size_t)M * 2048 * 2 <= WS_BR && WS_BR + (size_t)4 * M * 512 * 2 <= WS_U, "ws map 2");
constexpr size_t WS_RS = 1 * MiB;
constexpr int CW_TMO = 0, CW_BAR = 4096, CW_JOB = 16384;
constexpr int LDS_BYTES = 152 * 1024, MISC_OFF = MIX_JOBWORD;
constexpr int F8_DOWN_LAYER = DEPTH - 1;
constexpr int NWAVES = 8, NPH = 9 * DEPTH + 1;

#define XB_TMO      128
#define XB_XCNT(j)  (256  + 64 * (j))
#define XB_XSUB(j)  (1280 + 64 * (j))
#define XB_XGEN(j)  (2304 + 64 * (j))
#define XB_TOP      3328
#define XB_TOPGEN   3392
#define XCD_BAR_WORDS 3456
#define XB_SPIN_CAP (1u << 18)
__device__ __forceinline__ unsigned xb_ld(unsigned* p)              { return __hip_atomic_load(p, __ATOMIC_RELAXED, __HIP_MEMORY_SCOPE_AGENT); }
__device__ __forceinline__ unsigned xb_add(unsigned* p, unsigned v) { return __hip_atomic_fetch_add(p, v, __ATOMIC_RELAXED, __HIP_MEMORY_SCOPE_AGENT); }
__device__ __forceinline__ unsigned xb_xcc_id() { return (unsigned)__builtin_amdgcn_s_getreg((3 << 11) | 20) & 0xFu; }
#define XB_SPIN(cond, bar) do { unsigned _sp = 0; while (cond) { __builtin_amdgcn_s_sleep(1); \
    if ((++_sp & 255u) == 0u) { if (xb_ld(&(bar)[XB_TMO])) break; if (_sp > XB_SPIN_CAP) { atomicAdd(&(bar)[XB_TMO], 1u); break; } } } } while (0)
struct XcdBarrier { unsigned* bar; unsigned x; volatile LAS unsigned* st; };
__device__ __forceinline__ XcdBarrier xcd_barrier_post(unsigned* bar, volatile LAS unsigned* st) {
    XcdBarrier b; b.bar = bar; b.x = xb_xcc_id(); b.st = st;
    if (threadIdx.x == 0) (void)xb_add(&bar[XB_XCNT(b.x)], 1u);
    return b;
}
__device__ __forceinline__ void xcd_barrier_complete(unsigned* bar, unsigned x, unsigned& nloc, unsigned& nx) {
    const unsigned G = gridDim.x * gridDim.y * gridDim.z;
    unsigned sum, cnt, mine, sp = 0u;
    for (;;) {
        sum = 0u; cnt = 0u; mine = 0u;
#pragma unroll
        for (unsigned j = 0; j < 16; ++j) { const unsigned c = xb_ld(&bar[XB_XCNT(j)]); sum += c; cnt += (c > 0u) ? 1u : 0u; mine = (j == x) ? c : mine; }
        if (sum == G) break;
        __builtin_amdgcn_s_sleep(1);
        if ((++sp & 255u) == 0u) { if (xb_ld(&bar[XB_TMO])) break; if (sp > XB_SPIN_CAP) { atomicAdd(&bar[XB_TMO], 1u); break; } }
    }
    nloc = mine > 0u ? mine : 1u; nx = cnt > 0u ? cnt : 1u;
}
__device__ __forceinline__ void xcd_barrier(const XcdBarrier& b, const bool leader  ) {
    asm volatile("s_waitcnt vmcnt(0)" ::: "memory");
    __syncthreads();
    if (leader) {
        unsigned* bar = b.bar;
        __builtin_amdgcn_s_waitcnt(0);
        unsigned nloc = b.st[0], nx = b.st[1];
        if (nloc == 0u) { xcd_barrier_complete(bar, b.x, nloc, nx); b.st[0] = nloc; b.st[1] = nx; }
        const unsigned old = xb_add(&bar[XB_XSUB(b.x)], 1u);
        const unsigned gen = old / nloc;
        if (old + 1u == (gen + 1u) * nloc) {
            __builtin_amdgcn_fence(__ATOMIC_RELEASE, "agent");
            asm volatile("s_waitcnt vmcnt(0)" ::: "memory");
            const unsigned og = xb_add(&bar[XB_TOP], 1u);
            const unsigned tg = og / nx;
            if (og + 1u == (tg + 1u) * nx) xb_add(&bar[XB_TOPGEN], 1u);
            else XB_SPIN(xb_ld(&bar[XB_TOPGEN]) == tg, bar);
            __builtin_amdgcn_fence(__ATOMIC_ACQUIRE, "agent");
            xb_add(&bar[XB_XGEN(b.x)], 1u);
            asm volatile("s_waitcnt vmcnt(0)" ::: "memory");
        } else {
            XB_SPIN(xb_ld(&bar[XB_XGEN(b.x)]) == gen, bar);
            __builtin_amdgcn_fence(__ATOMIC_ACQUIRE, "agent");
            asm volatile("s_waitcnt vmcnt(0)" ::: "memory");
        }
    }
    __syncthreads();
}

__device__ __forceinline__ int map_in(int n) {
    if (n < 1024) return n;
    if (n < 1536) return 4864 + (n - 1024);
    if (n < 2048) return 1024 + (n - 1536);
    if (n < 2560) return 4864 + 512 + (n - 2048);
    if (n < 2576) return 4608 + (n - 2560);
    if (n < 3088) return 1536 + (n - 2576);
    if (n < 4112) return 2048 + (n - 3088);
    if (n < 4624) return 4864 + 1024 + (n - 4112);
    if (n < 5136) return 3072 + (n - 4624);
    if (n < 5144) return 4624 + (n - 5136);
    if (n < 6168) return 3584 + (n - 5144);
    return 4864 + 1536 + (n - 6168);
}
template <bool MAPIN, bool F8 = false>
__device__ __forceinline__ void transpose_item(const float* W, int K, int N, bf16* WT, int row_off, LAS float* scr, int item, int lane, int ldw = 0  , int coff = 0, const float* gk = nullptr  ) {
    const int nblk = (N + 63) / 64, kb = item / nblk, nb = item % nblk, k0 = 64 * kb, n0 = 64 * nb;
    const bool cv = (n0 + 2 * (lane & 31)) < N;
    { float2 wv[32];
      const float* wp = W + (size_t)(k0 + (lane >> 5)) * N + n0 + 2 * (lane & 31);
#pragma unroll
      for (int i = 0; i < 32; ++i) wv[i] = cv ? *(const float2*)(wp + (size_t)(2 * i) * N) : make_float2(0.f, 0.f);
#pragma unroll
      for (int i = 0; i < 32; ++i) { LAS float* d = scr + (2 * i + (lane >> 5)) * 65 + 2 * (lane & 31); d[0] = wv[i].x; d[1] = wv[i].y; } }
    asm volatile("s_waitcnt lgkmcnt(0)" ::: "memory");
    const int c = lane & 7;
    f32x4 g0 = (f32x4){1.f, 1.f, 1.f, 1.f}, g1 = g0; if (gk) { g0 = *(const f32x4*)(gk + k0 + 8 * c); g1 = *(const f32x4*)(gk + k0 + 8 * c + 4); }
#pragma unroll
    for (int j = 0; j < 8; ++j) { const int n = (lane >> 3) + 8 * j; const LAS float* s = scr + (8 * c) * 65 + n;
        u32x4 o; o.x = pk2(s[0 * 65] * g0[0], s[1 * 65] * g0[1]); o.y = pk2(s[2 * 65] * g0[2], s[3 * 65] * g0[3]); o.z = pk2(s[4 * 65] * g1[0], s[5 * 65] * g1[1]); o.w = pk2(s[6 * 65] * g1[2], s[7 * 65] * g1[3]);
        if (F8) { u32x2 o8; o8.x = pk4_fp8(s[0 * 65] * F8_SC_W, s[1 * 65] * F8_SC_W, s[2 * 65] * F8_SC_W, s[3 * 65] * F8_SC_W); o8.y = pk4_fp8(s[4 * 65] * F8_SC_W, s[5 * 65] * F8_SC_W, s[6 * 65] * F8_SC_W, s[7 * 65] * F8_SC_W);
            if (n0 + n < N) *(u32x2*)((unsigned char*)WT + (size_t)(row_off + n0 + n) * (ldw ? ldw : 2 * K) + k0 + 8 * c) = o8; }
        else if (n0 + n < N) { const int drow = MAPIN ? map_in(n0 + n) : row_off + n0 + n; *(u32x4*)(WT + (size_t)drow * (ldw ? ldw : K) + coff + k0 + 8 * c) = o; } }
    asm volatile("s_waitcnt lgkmcnt(0)" ::: "memory");
}
struct WArgs { const float *w_in, *w_gate, *w_branch, *w_out, *w_up, *w_down; bf16 *Win_t, *Wg_t, *Wb_t, *Wo_t, *Wup_t, *Wdn_t; const float *g_in, *g_up; int dn8; };
__device__ __forceinline__ void weights_phase(LAS unsigned char* lds, const WArgs& Wa, int gw, int NGW, int wave, int lane) {
    LAS float* scr = (LAS float*)(lds + wave * 16640);
    constexpr int I_IN = 32 * 105, I_G = 32 * 32, I_B = 8 * 32, I_O = 32 * 32, I_UP = 32 * 128, I_DN = 128 * 32;
    constexpr int NITEMS = I_IN + 4 * I_G + 4 * I_B + I_O + I_UP + I_DN;
    for (int it = gw; it < NITEMS; it += NGW) {
        int r = it;
        if (r < I_IN) { transpose_item<true>(Wa.w_in, 2048, NIN, Wa.Win_t, 0, scr, r, lane, 0, 0, Wa.g_in); continue; } r -= I_IN;
        if (r < 4 * I_G) { const int bi = r / I_G; transpose_item<false, true>(Wa.w_gate + (size_t)bi * 2048 * 2048, 2048, 2048, Wa.Wg_t, bi * 2048, scr, r % I_G, lane); continue; } r -= 4 * I_G;
        if (r < 4 * I_B) { const int bi = r / I_B; transpose_item<false>(Wa.w_branch + (size_t)bi * 512 * 2048, 512, 2048, Wa.Wb_t, 0, scr, r % I_B, lane, 2048, bi * 512); continue; } r -= 4 * I_B;
        if (r < I_O) { transpose_item<false>(Wa.w_out, 2048, 2048, Wa.Wo_t, 0, scr, r, lane); continue; } r -= I_O;
        if (r < I_UP) { transpose_item<false>(Wa.w_up, 2048, 8192, Wa.Wup_t, 0, scr, r, lane, 0, 0, Wa.g_up); continue; } r -= I_UP;
        if (Wa.dn8) transpose_item<false, true>(Wa.w_down, 8192, 2048, Wa.Wdn_t, 0, scr, r, lane, 8192);
        else transpose_item<false>(Wa.w_down, 8192, 2048, Wa.Wdn_t, 0, scr, r, lane);
    }
    { unsigned z0 = 0u; LAUNDER(z0); u32x4 z; z.x = z.y = z.z = z.w = z0; u32x4* zp = (u32x4*)(Wa.Win_t + (size_t)4632 * 2048);
      for (int i = gw * 64 + lane; i < 232 * 256; i += NGW * 64) zp[i] = z; }
}

__device__ __forceinline__ float wave_sum(float v) {
#pragma unroll
    for (int o = 1; o < 64; o <<= 1) v += __shfl_xor(v, o);
    return v;
}
template <bool XIN_F32> struct NormRow;
template <> struct NormRow<true> { f32x4 xf[4][2]; u32x4 yb[4]; };
template <> struct NormRow<false> { u32x4 xb[4]; u32x4 yb[4]; };
template <bool XIN_F32>
__device__ __forceinline__ void norm_load(NormRow<XIN_F32>& R, const void* x_old_, const bf16* y, int m, int lane) {
    if constexpr (XIN_F32) { const f32x4* xr = (const f32x4*)((const float*)x_old_ + (size_t)m * D) + 2 * lane;
#pragma unroll
        for (int j = 0; j < 4; ++j) { R.xf[j][0] = xr[128 * j]; R.xf[j][1] = xr[128 * j + 1]; } }
    else { const u32x4* xr = (const u32x4*)((const bf16*)x_old_ + (size_t)m * D) + lane;
#pragma unroll
        for (int j = 0; j < 4; ++j) R.xb[j] = xr[64 * j]; }
    if (y) { const u32x4* yr = (const u32x4*)(y + (size_t)m * D) + lane;
#pragma unroll
        for (int j = 0; j < 4; ++j) R.yb[j] = yr[64 * j]; }
}
template <bool XIN_F32, bool XOUT_F32, bool H8 = false>
__device__ __forceinline__ void norm_finish(NormRow<XIN_F32>& R, const bf16* y, const f32x4 (&gp)[4][2], void* x_out_, const f32x4 (&gq)[4][2], bf16* h_out, int m, int lane, unsigned char* h8_out = nullptr, float* rs_out = nullptr) {
    f32x4 v[4][2];
#pragma unroll
    for (int j = 0; j < 4; ++j) {
        if constexpr (XIN_F32) { v[j][0] = R.xf[j][0]; v[j][1] = R.xf[j][1]; }
        else { const u32x4 t = R.xb[j]; v[j][0] = (f32x4){bf2f(t.x & 0xffffu), bf2f(t.x >> 16), bf2f(t.y & 0xffffu), bf2f(t.y >> 16)}; v[j][1] = (f32x4){bf2f(t.z & 0xffffu), bf2f(t.z >> 16), bf2f(t.w & 0xffffu), bf2f(t.w >> 16)}; }
    }
    if (y) {
        f32x4 w[4][2]; float s = 0.f;
#pragma unroll
        for (int j = 0; j < 4; ++j) { const u32x4 t = R.yb[j];
            w[j][0] = (f32x4){bf2f(t.x & 0xffffu), bf2f(t.x >> 16), bf2f(t.y & 0xffffu), bf2f(t.y >> 16)}; w[j][1] = (f32x4){bf2f(t.z & 0xffffu), bf2f(t.z >> 16), bf2f(t.w & 0xffffu), bf2f(t.w >> 16)};
#pragma unroll
            for (int k = 0; k < 2; ++k) s += (w[j][k][0] * w[j][k][0] + w[j][k][1] * w[j][k][1]) + (w[j][k][2] * w[j][k][2] + w[j][k][3] * w[j][k][3]); }
        const float rs = 1.0f / sqrtf(wave_sum(s) * (1.0f / D) + 1e-6f);
#pragma unroll
        for (int j = 0; j < 4; ++j)
#pragma unroll
            for (int k = 0; k < 2; ++k) v[j][k] = v[j][k] + w[j][k] * rs * gp[j][k];
    }
    if (x_out_) {
        if (XOUT_F32) { f32x4* xo = (f32x4*)((float*)x_out_ + (size_t)m * D) + 2 * lane;
#pragma unroll
            for (int j = 0; j < 4; ++j) { xo[128 * j] = v[j][0]; xo[128 * j + 1] = v[j][1]; } }
        else { u32x4* xo = (u32x4*)((bf16*)x_out_ + (size_t)m * D) + lane;
#pragma unroll
            for (int j = 0; j < 4; ++j) { u32x4 o; o.x = pk2(v[j][0][0], v[j][0][1]); o.y = pk2(v[j][0][2], v[j][0][3]); o.z = pk2(v[j][1][0], v[j][1][1]); o.w = pk2(v[j][1][2], v[j][1][3]); xo[64 * j] = o;
                v[j][0] = (f32x4){bf2f(o.x & 0xffffu), bf2f(o.x >> 16), bf2f(o.y & 0xffffu), bf2f(o.y >> 16)}; v[j][1] = (f32x4){bf2f(o.z & 0xffffu), bf2f(o.z >> 16), bf2f(o.w & 0xffffu), bf2f(o.w >> 16)}; } }
    }
    if (h_out || H8 || rs_out) {
        float s = 0.f;
#pragma unroll
        for (int j = 0; j < 4; ++j)
#pragma unroll
            for (int k = 0; k < 2; ++k) s += (v[j][k][0] * v[j][k][0] + v[j][k][1] * v[j][k][1]) + (v[j][k][2] * v[j][k][2] + v[j][k][3] * v[j][k][3]);
        const float rs = 1.0f / sqrtf(wave_sum(s) * (1.0f / D) + 1e-6f);
        if (rs_out && lane == 0) rs_out[m] = rs;
        if (h_out || H8) {
        u32x4* ho = (u32x4*)(h_out + (size_t)m * D) + lane;
#pragma unroll
        for (int j = 0; j < 4; ++j) { const f32x4 a = v[j][0] * rs * gq[j][0], b = v[j][1] * rs * gq[j][1]; u32x4 o; o.x = pk2(a[0], a[1]); o.y = pk2(a[2], a[3]); o.z = pk2(b[0], b[1]); o.w = pk2(b[2], b[3]); if (h_out) ho[64 * j] = o;
            if (H8) { u32x2 o8; o8.x = pk4_fp8(a[0] * F8_SC_H, a[1] * F8_SC_H, a[2] * F8_SC_H, a[3] * F8_SC_H); o8.y = pk4_fp8(b[0] * F8_SC_H, b[1] * F8_SC_H, b[2] * F8_SC_H, b[3] * F8_SC_H); ((u32x2*)(h8_out + (size_t)m * (2 * D)) + lane)[64 * j] = o8; } }
        }
    }
}
template <bool XIN_F32, bool XOUT_F32, bool H8 = false>
__device__ __forceinline__ void norm_phase(const void* x_old_, const bf16* y, const float* g_post, void* x_out_, const float* g_pre, bf16* h_out, int gw, int NGW, int lane, unsigned char* h8_out = nullptr, float* rs_out = nullptr) {
    f32x4 gp[4][2], gq[4][2]; float zf = 0.f; LAUNDER(zf);
#pragma unroll
    for (int j = 0; j < 4; ++j)
#pragma unroll
        for (int k = 0; k < 2; ++k) { gp[j][k] = y ? ((const f32x4*)g_post)[2 * lane + 128 * j + k] : (f32x4){zf, zf, zf, zf}; gq[j][k] = (h_out || H8) ? ((const f32x4*)g_pre)[2 * lane + 128 * j + k] : (f32x4){zf, zf, zf, zf}; }
    NormRow<XIN_F32> Ra, Rb;
    int m = gw;
    if (m < M) norm_load<XIN_F32>(Ra, x_old_, y, m, lane);
    for (; m < M; m += 2 * NGW) {
        const int m1 = m + NGW, m2 = m + 2 * NGW;
        if (m1 < M) norm_load<XIN_F32>(Rb, x_old_, y, m1, lane);
        norm_finish<XIN_F32, XOUT_F32, H8>(Ra, y, gp, x_out_, gq, h_out, m, lane, h8_out, rs_out);
        if (m2 < M) norm_load<XIN_F32>(Ra, x_old_, y, m2, lane);
        if (m1 < M) norm_finish<XIN_F32, XOUT_F32, H8>(Rb, y, gp, x_out_, gq, h_out, m1, lane, h8_out, rs_out);
    }
}

#ifndef PH_MASK
#define PH_MASK 0x1FF
#endif
#ifndef REP_MIX
#define REP_MIX 1
#endif
#ifndef REP_DIFF
#define REP_DIFF 1
#endif
#ifndef REP_BAND
#define REP_BAND 1
#endif
#ifndef REPJ_GLA
#define REPJ_GLA 1
#endif
#ifndef REPJ_ML
#define REPJ_ML 1
#endif
#ifndef REP_SEQ
#define REP_SEQ 1
#endif
#ifndef REP_WCONV
#define REP_WCONV 1
#endif
#ifndef REP_NORM
#define REP_NORM 1
#endif
#ifndef REP_P6
#define REP_P6 1
#endif
#ifndef REP_GEMM
#define REP_GEMM 1
#endif
#ifndef REP_G1
#define REP_G1 REP_GEMM
#endif
#ifndef REP_G3
#define REP_G3 REP_GEMM
#endif
#ifndef REP_G4
#define REP_G4 REP_GEMM
#endif
#ifndef REP_G5
#define REP_G5 REP_GEMM
#endif
#ifndef REP_G7
#define REP_G7 REP_GEMM
#endif
#ifndef REP_G8
#define REP_G8 REP_GEMM
#endif

struct Args { const float* in[23]; float* out; unsigned char* ws; float lam_init[4]; int ph_lo, ph_hi, one_launch, pad; };
typedef const __attribute__((address_space(4))) Args* CArgs;
#define PHASE_ARGS() CArgs ap = (CArgs)__builtin_amdgcn_kernarg_segment_ptr(); asm volatile("" : "+s"(ap)); unsigned char* ws = ap->ws; (void)ws; int lane = LANE_ID(); LAUNDER(lane); (void)lane; int bxl = bx; asm volatile("" : "+s"(bxl)); (void)bxl
__global__ void __launch_bounds__(NWAVES * 64, 2) fwd_kernel(Args args_unused) {
    extern __shared__ __attribute__((aligned(16))) unsigned char lds_raw[];
    LAS unsigned char* lds = (LAS unsigned char*)lds_raw;
    volatile LAS unsigned* MISC = (volatile LAS unsigned*)(lds + MISC_OFF);
    const int wave = __builtin_amdgcn_readfirstlane((int)threadIdx.x >> 6); const int g_wave_id_sgpr = wave;
    const int lane0 = LANE_ID(), tid = wave * 64 + lane0;
    const int G = gridDim.x, bx = blockIdx.x;
    const int vcu = (G % 8 == 0) ? (bx % 8) * (G / 8) + bx / 8 : bx;
    const int gw = vcu * NWAVES + wave, NGW = G * NWAVES;
    if (tid < 16) MISC[tid] = 0u;
    __syncthreads();
    int lo, hi; XcdBarrier bar;
    int ap_one_launch;
    { PHASE_ARGS(); lo = ap->ph_lo; hi = ap->ph_hi; ap_one_launch = ap->one_launch; unsigned* ctl = (unsigned*)(ws + WS_CTL); bar.bar = ctl + CW_BAR; bar.x = 0; bar.st = nullptr;
      if (ap->one_launch) bar = xcd_barrier_post(ctl + CW_BAR, MISC + 2); }
#define IN(k) (lo <= (k) && (k) < hi)
#define SEAM(k) do { if (IN((k) + 1)) xcd_barrier(bar, WAVE_ID() == 0 && LANE_ID() == 0); } while (0)
#define WSP(T_, off) ((T_*)(ws + (off)))

    for (int l = 0; l < DEPTH; ++l) {
        const int pb = 9 * l;
        if (((PH_MASK >> 0) & 1) && IN(pb + 0)) {
            PHASE_ARGS();
            WArgs Wa{ap->in[3] + (size_t)l * 2048 * NIN, ap->in[16] + (size_t)l * 4 * 2048 * 2048, ap->in[15] + (size_t)l * 4 * 512 * 2048, ap->in[18] + (size_t)l * 2048 * 2048,
                     ap->in[21] + (size_t)l * 2048 * 8192, ap->in[22] + (size_t)l * 8192 * 2048, WSP(bf16, WS_WIN), WSP(bf16, WS_WG), WSP(bf16, WS_WB), WSP(bf16, WS_WO), WSP(bf16, WS_WUP), WSP(bf16, WS_WDN), ap->in[1] + (size_t)l * D, ap->in[19] + (size_t)l * D, l == F8_DOWN_LAYER ? 1 : 0};
            for (int rep = 0; rep < REP_NORM; ++rep) {
            for (int rw = 0; rw < REP_WCONV; ++rw) weights_phase(lds, Wa, gw, NGW, wave, lane);
            if (l == 0) norm_phase<true, false, true>(ap->in[0], nullptr, nullptr, WSP(bf16, WS_XB), ap->in[1], nullptr, gw, NGW, lane, ws + WS_H8, WSP(float, WS_RS));
            else norm_phase<false, false, true>(WSP(bf16, WS_XB), WSP(bf16, WS_Y2), ap->in[20] + (size_t)(l - 1) * D, rep < REP_NORM - 1 ? WSP(bf16, WS_U) : WSP(bf16, WS_XB), ap->in[1] + (size_t)l * D, nullptr, gw, NGW, lane, ws + WS_H8, WSP(float, WS_RS));
            }
            SEAM(pb + 0);
        }
        if (((PH_MASK >> 1) & 1) && IN(pb + 1)) {
            PHASE_ARGS();
            pg8::OrdInProj S{(const char*)(ws + WS_XB), (const char*)(ws + WS_WIN), (size_t)256 * 2048 * 2, G, bxl};
            pg8::EpiBf<0> E{WSP(bf16, WS_U), ULD, WSP(bf16, WS_VT), M, 1.f, WSP(float, WS_RS)};
            for (int rep = 0; rep < REP_G1; ++rep) pg8::gemm_phase(lds, WAVE_ID(), 2048, S, E);
            SEAM(pb + 1);
        }
        if (((PH_MASK >> 2) & 1) && IN(pb + 2)) {
#define MIX_ARGS() PHASE_ARGS(); MixArgs A{}; A.U = WSP(bf16, WS_U); A.VT = WSP(bf16, WS_VT); A.BR = WSP(bf16, WS_BR); \
            A.diff_lambda = ap->in[4] + l * 256; A.diff_norm = ap->in[5] + l * 512; A.gla_wgu = ap->in[6] + l * 4096; A.gla_bg = ap->in[7] + l * 256; A.gla_norm = ap->in[8] + l * 512; \
            A.conv_w = ap->in[9] + l * 4096; A.conv_b = ap->in[10] + l * 1024; A.b_i = ap->in[11] + l * 4; A.b_f = ap->in[12] + l * 4; A.ml_norm = ap->in[13] + l * 512; A.rel_bias = ap->in[14] + l * 1028; \
            A.lam_init = ap->lam_init[l]; A.ST = WSP(float, WS_MG); unsigned* cnt = (unsigned*)(ws + WS_CTL) + CW_JOB + 256 * l + 1024 * rep
            for (int rep = 0; rep < REP_MIX; ++rep) {
            int jq;
            { MIX_ARGS(); MIX_FIRST(cnt, jq); }
            if (JOB_MASK & 2) { MIX_ARGS(); MIX_RANGE(cnt, jq, JA0, JA1, mlstm_job(lds, WAVE_ID(), A, job >> 2, job & 3, 0, 2)); }
            if (JOB_MASK & 2) { MIX_ARGS(); MIX_RANGE(cnt, jq, JA1, JA2, mlstm_job(lds, WAVE_ID(), A, (job % NBH) >> 2, job & 3, 1 + job / NBH, 1)); }
            if (JOB_MASK & 1) { MIX_ARGS(); MIX_RANGE(cnt, jq, JA2, JA3, gla_job(lds, WAVE_ID(), A, job >> 2, job & 3, 0, 2)); }
            if (JOB_MASK & 1) { MIX_ARGS(); MIX_RANGE(cnt, jq, JA3, JA4, gla_job(lds, WAVE_ID(), A, (job % NBH) >> 2, job & 3, 1 + job / NBH, 1)); }
            if (JOB_MASK & 4) { MIX_ARGS(); MIX_RANGE(cnt, jq, JA4, JA5, diff_attn_job(lds, WAVE_ID(), A, (job % NBH) >> 2, job & 3, (T / 128 - 1) - job / NBH)); }
            if (JOB_MASK & 8) { MIX_ARGS(); MIX_RANGE(cnt, jq, JA5, JA6, band_attn_job(lds, WAVE_ID(), A, (job % NBH) >> 2, job & 3, job / NBH)); }
            if (ap_one_launch) xcd_barrier(bar, WAVE_ID() == 0 && LANE_ID() == 0);
            { MIX_ARGS(); MIX_FIRST(cnt + 64, jq); }
            if (JOB_MASK & 2) { MIX_ARGS(); MIX_RANGE(cnt + 64, jq, JB0, JB1, mlstm_job(lds, WAVE_ID(), A, (job % NBH) >> 2, job & 3, 1 + job / NBH, 3)); }
            if (JOB_MASK & 1) { MIX_ARGS(); MIX_RANGE(cnt + 64, jq, JB1, JB2, gla_job(lds, WAVE_ID(), A, (job % NBH) >> 2, job & 3, 1 + job / NBH, 3)); }
            if (JOB_MASK & 4) { MIX_ARGS(); MIX_RANGE(cnt + 64, jq, JB2, JB3, diff_attn_job(lds, WAVE_ID(), A, ((job + NJ_DIFF_A) % NBH) >> 2, (job + NJ_DIFF_A) & 3, (T / 128 - 1) - (job + NJ_DIFF_A) / NBH)); }
            }
            if (IN(pb + 4)) xcd_barrier(bar, WAVE_ID() == 0 && LANE_ID() == 0);
        }
        if (((PH_MASK >> 4) & 1) && IN(pb + 4)) {
            PHASE_ARGS();
            pg8::OrdGateFused S{(const char*)(ws + WS_H8), (const char*)(ws + WS_WG), (const char*)(ws + WS_BR), (const char*)(ws + WS_WB), G, bxl};
            pg8::EpiGateFused E{(u32x4*)(ws + WS_P) + (size_t)bxl * 16384, (u32x4*)(ws + WS_P + 128 * MiB) + (size_t)bxl * 16384, WSP(bf16, WS_MG), ap->in[17] + (size_t)l * 4 * 2048};
            for (int rep = 0; rep < REP_G4; ++rep) pg8::gemm_phase<true>(lds, WAVE_ID(), 2048, S, E);
            SEAM(pb + 4);
        }
        if (((PH_MASK >> 5) & 1) && IN(pb + 5)) {
            PHASE_ARGS();
            pg8::OrdPlain S{(const char*)(ws + WS_MG), (const char*)(ws + WS_WO), (size_t)256 * 2048 * 2, (size_t)256 * 2048 * 2, 0, 128, 8, 0, G, bxl, 32};
            pg8::EpiBf<0> E{WSP(bf16, WS_Y), 2048, WSP(bf16, WS_Y), 2048, 1.f, nullptr};
            for (int rep = 0; rep < REP_G5; ++rep) pg8::gemm_phase(lds, WAVE_ID(), 2048, S, E);
            SEAM(pb + 5);
        }
        if (((PH_MASK >> 6) & 1) && IN(pb + 6)) {
            PHASE_ARGS();
            for (int rep = 0; rep < REP_P6; ++rep)
            { if (l == 0) norm_phase<true, false>(ap->in[0], WSP(bf16, WS_Y), ap->in[2] + (size_t)l * D, rep < REP_P6 - 1 ? WSP(bf16, WS_BR) : WSP(bf16, WS_XB), ap->in[19] + (size_t)l * D, nullptr, gw, NGW, lane, nullptr, WSP(float, WS_RS));
              else norm_phase<false, false>(WSP(bf16, WS_XB), WSP(bf16, WS_Y), ap->in[2] + (size_t)l * D, rep < REP_P6 - 1 ? WSP(bf16, WS_BR) : WSP(bf16, WS_XB), ap->in[19] + (size_t)l * D, nullptr, gw, NGW, lane, nullptr, WSP(float, WS_RS)); }
            SEAM(pb + 6);
        }
        if (((PH_MASK >> 7) & 1) && IN(pb + 7)) {
            PHASE_ARGS();
            pg8::OrdPlain S{(const char*)(ws + WS_XB), (const char*)(ws + WS_WUP), (size_t)256 * 2048 * 2, (size_t)256 * 2048 * 2, 0, 128, 32, 0, G, bxl, 32};
            if (l == F8_DOWN_LAYER) { pg8::EpiBf<1, true> E{WSP(bf16, WS_HID), 8192, WSP(bf16, WS_HID), 8192, 1.f, WSP(float, WS_RS)}; pg8::gemm_phase(lds, WAVE_ID(), 2048, S, E); }
            else { pg8::EpiBf<1> E{WSP(bf16, WS_HID), 8192, WSP(bf16, WS_HID), 8192, 1.f, WSP(float, WS_RS)};
            for (int rep = 0; rep < REP_G7; ++rep) pg8::gemm_phase(lds, WAVE_ID(), 2048, S, E); }
            SEAM(pb + 7);
        }
        if (((PH_MASK >> 8) & 1) && IN(pb + 8)) {
            PHASE_ARGS();
            if (l == F8_DOWN_LAYER) {
                pg8::OrdPlain S{(const char*)(ws + WS_HID), (const char*)(ws + WS_WDN), (size_t)256 * 8192, (size_t)256 * 8192, 0, 128, 8, 0, G, bxl, 64, 1};
                pg8::EpiBf<0> E{WSP(bf16, WS_Y2), 2048, WSP(bf16, WS_Y2), 2048, 1.f / (F8_SC_HID * F8_SC_W), nullptr};
                pg8::gemm_phase<true>(lds, WAVE_ID(), 4096, S, E); }
            else {
            pg8::OrdPlain S{(const char*)(ws + WS_HID), (const char*)(ws + WS_WDN), (size_t)256 * 8192 * 2, (size_t)256 * 8192 * 2, 0, 128, 8, 0, G, bxl, 128};
            pg8::EpiBf<0> E{WSP(bf16, WS_Y2), 2048, WSP(bf16, WS_Y2), 2048, 1.f, nullptr};
            for (int rep = 0; rep < REP_G8; ++rep) pg8::gemm_phase(lds, WAVE_ID(), 8192, S, E); }
            SEAM(pb + 8);
        }
    }
    if (IN(9 * DEPTH)) { PHASE_ARGS(); norm_phase<false, true>(WSP(bf16, WS_XB), WSP(bf16, WS_Y2), ap->in[20] + (size_t)(DEPTH - 1) * D, ap->out, nullptr, nullptr, gw, NGW, lane); }
#undef IN
#undef SEAM
}

extern "C" void kernel_launch(void* const* d_in, const int* in_sizes, int n_in, void* d_out, int out_size, void* d_ws, size_t ws_size, hipStream_t stream) {
    static int grid = 0;
    if (grid == 0) {
        if (n_in != 23 || in_sizes[0] != M * D || out_size != M * D || ws_size < WS_END) { fprintf(stderr, "kernel_launch: unexpected shapes / workspace (n_in %d, ws %zu, need %zu); nothing launched\n", n_in, ws_size, (size_t)WS_END); grid = -1; return; }
        int dev = 0, cus = 0, per_cu = 0;
        if (hipGetDevice(&dev) != hipSuccess || hipDeviceGetAttribute(&cus, hipDeviceAttributeMultiprocessorCount, dev) != hipSuccess) { grid = -1; return; }
        if (hipFuncSetAttribute((const void*)fwd_kernel, hipFuncAttributeMaxDynamicSharedMemorySize, LDS_BYTES) != hipSuccess) { fprintf(stderr, "kernel_launch: hipFuncSetAttribute failed\n"); grid = -1; return; }
        if (hipOccupancyMaxActiveBlocksPerMultiprocessor(&per_cu, (const void*)fwd_kernel, NWAVES * 64, LDS_BYTES) != hipSuccess || per_cu < 1) fprintf(stderr, "kernel_launch: occupancy query reports %d\n", per_cu);
        (void)hipGetLastError();
        grid = cus;
    }
    if (grid < 0) return;
    if (hipMemsetAsync((char*)d_ws + WS_CTL, 0, CTL_ZERO_BYTES, stream) != hipSuccess) return;
    Args a{};
    for (int i = 0; i < 23; ++i) a.in[i] = (const float*)d_in[i];
    a.out = (float*)d_out; a.ws = (unsigned char*)d_ws;
    for (int l = 0; l < 4; ++l) a.lam_init[l] = (float)(0.8 - 0.6 * exp(-0.3 * (double)l));
    a.ph_lo = 0; a.ph_hi = NPH; a.one_launch = 1;
    hipLaunchKernelGGL(fwd_kernel, dim3(grid), dim3(NWAVES * 64), LDS_BYTES, stream, a);
    const hipError_t le = hipPeekAtLastError();
    if (le != hipSuccess) fprintf(stderr, "kernel_launch: launch failed: %s\n", hipGetErrorName(le));
}
```

```cpp
#include <hip/hip_runtime.h>
#include <cstdio>
#include <cstdint>
#include <cmath>
#define LAS __attribute__((address_space(3)))
#define FEXP(x) __expf(x)
#define FEXP2(x) __builtin_amdgcn_exp2f(x)
#define FLOG(x) __logf(x)
#define FRSQRT(x) __builtin_amdgcn_rsqf(x)
#define FRCP(x) __builtin_amdgcn_rcpf(x)
#define LAUNDER(x) asm volatile("" : "+v"(x))
#define UNIFORM(x) __builtin_amdgcn_readfirstlane(x)
__device__ __forceinline__ int lane_id_asm() { int l; asm volatile("v_mbcnt_lo_u32_b32 %0, -1, 0\n\tv_mbcnt_hi_u32_b32 %0, -1, %0" : "=v"(l)); return l; }
#define LANE_ID() lane_id_asm()
#define WAVE_ID() (g_wave_id_sgpr)
#define CFENCE() asm volatile("" ::: "memory")
#define SCHED_BAR() __builtin_amdgcn_sched_barrier(0)
#define SETPRIO(x) __builtin_amdgcn_s_setprio(x)

typedef unsigned short bf16;
typedef short bf16x8 __attribute__((ext_vector_type(8)));
typedef short bf16x4 __attribute__((ext_vector_type(4)));
typedef float f32x4 __attribute__((ext_vector_type(4)));
typedef float f32x16 __attribute__((ext_vector_type(16)));
typedef unsigned u32x4 __attribute__((ext_vector_type(4)));
typedef unsigned u32x2 __attribute__((ext_vector_type(2)));

constexpr int NB = 8, T = 4096;
constexpr int M = NB * T, D = 2048, NCH = T / 64, DEPTH = 4, DFF = 8192, NIN = 6680;
constexpr int ULD = 4864;
constexpr int U_DQ = 0, U_DK = 512, U_GQ = 1024, U_GK = 1280, U_GR = 1536, U_MQ = 2048, U_MK = 2560, U_MO = 3072, U_CQ = 3584, U_CK = 4096, U_GL = 4608, U_MI = 4624, U_MF = 4628;
constexpr int V_D = 0, V_G = 512, V_M = 1024, V_C = 1536;

__device__ __forceinline__ float bf2f(unsigned b) { return __builtin_bit_cast(float, b << 16); }
typedef float f32x2n __attribute__((ext_vector_type(2)));
typedef __bf16 bf16x2n __attribute__((ext_vector_type(2)));
__device__ __forceinline__ unsigned pk2(float lo, float hi) { const f32x2n v = {lo, hi}; return __builtin_bit_cast(unsigned, __builtin_convertvector(v, bf16x2n)); }
__device__ __forceinline__ unsigned f2bf(float f) { return pk2(f, 0.f) & 0xffffu; }
__device__ __forceinline__ f32x16 mfma32(bf16x8 a, bf16x8 b, f32x16 c) {
    return __builtin_amdgcn_mfma_f32_32x32x16_bf16(a, b, c, 0, 0, 0);
}
struct MixArgs {
    const bf16* U; const bf16* VT; bf16* BR;
    const float* diff_lambda; const float* diff_norm; const float* gla_wgu; const float* gla_bg; const float* gla_norm;
    const float* conv_w; const float* conv_b; const float* b_i; const float* b_f; const float* ml_norm; const float* rel_bias;
    float* ST;
    float lam_init; int pad_;
};
constexpr int KP = 272, VP = 136, KT_BYTES = 64 * KP, STG = KT_BYTES + 128 * VP;
constexpr float LOG2E = 1.4426950408889634f;

__device__ __forceinline__ bf16x8 ldfrag(const LAS unsigned char* p) { return *(const LAS bf16x8*)p; }
__device__ __forceinline__ bf16x8 ldfrag2(const LAS unsigned char* p) { const bf16x4 a = *(const LAS bf16x4*)p, b = *(const LAS bf16x4*)(p + 16); return __builtin_shufflevector(a, b, 0, 1, 2, 3, 4, 5, 6, 7); }
__device__ __forceinline__ u32x2 pack4(float a, float b, float c, float d) { u32x2 w; w.x = pk2(a, b); w.y = pk2(c, d); return w; }
__device__ __forceinline__ bf16x8 pack8f(const f32x16& x, int s) { u32x4 w; w.x = pk2(x[8 * s], x[8 * s + 1]); w.y = pk2(x[8 * s + 2], x[8 * s + 3]); w.z = pk2(x[8 * s + 4], x[8 * s + 5]); w.w = pk2(x[8 * s + 6], x[8 * s + 7]); return __builtin_bit_cast(bf16x8, w); }
__device__ __forceinline__ float fsigmoid(float x) { return FRCP(1.0f + FEXP(-x)); }
__device__ __forceinline__ float flogsig(float x) { return fminf(x, 0.f) - FLOG(1.0f + FEXP(-fabsf(x))); }
__device__ __forceinline__ f32x16 zero16() { f32x16 z; for (int i = 0; i < 16; ++i) z[i] = 0.f; return z; }

struct StageRegs { u32x4 w[4]; };
__device__ __forceinline__ void stage_load_k(StageRegs& R, const bf16* kbase  , int tid) {
#pragma unroll
    for (int i = 0; i < 4; ++i) { const int c = tid + 512 * i; R.w[i] = *(const u32x4*)(kbase + (size_t)(c >> 4) * ULD + (c & 15) * 8); }
}
__device__ __forceinline__ void stage_load_v(StageRegs& R, const bf16* vbase  , int tid) {
#pragma unroll
    for (int i = 0; i < 4; ++i) { const int c = tid + 512 * i; R.w[i] = *(const u32x4*)(vbase + (size_t)(c >> 4) * M + (c & 15) * 8); }
}
__device__ __forceinline__ void stage_store_k(const StageRegs& R, LAS unsigned char* buf, int tid) {
#pragma unroll
    for (int i = 0; i < 4; ++i) { const int c = tid + 512 * i; const int krow = c >> 4; *(LAS u32x4*)(buf + (krow >> 6) * STG + (krow & 63) * KP + (c & 15) * 16) = R.w[i]; }
}
__device__ __forceinline__ void stage_store_v(const StageRegs& R, LAS unsigned char* buf, int tid) {
#pragma unroll
    for (int i = 0; i < 4; ++i) { const int c = tid + 512 * i; const int vt = (c >> 3) & 1;
        LAS unsigned char* vp = buf + vt * STG + KT_BYTES + (c >> 4) * VP + (c & 7) * 16; u32x2 lo, hi; lo.x = R.w[i].x; lo.y = R.w[i].y; hi.x = R.w[i].z; hi.y = R.w[i].w; *(LAS u32x2*)vp = lo; *(LAS u32x2*)(vp + 8) = hi; }
}
__device__ __forceinline__ float xhalf_max(float x) {
    const auto r = __builtin_amdgcn_permlane32_swap(__builtin_bit_cast(unsigned, x), __builtin_bit_cast(unsigned, x), false, false);
    return fmaxf(__builtin_bit_cast(float, r[0]), __builtin_bit_cast(float, r[1]));
}
__device__ __forceinline__ void softmax_x(f32x16 (&x)[2], float& m_run, float& l_run, f32x16 (&o)[4], bf16x8 (&pf)[2][2]) {
    float mx = x[0][0];
#pragma unroll
    for (int q = 0; q < 2; ++q)
#pragma unroll
        for (int i = 0; i < 16; ++i) mx = fmaxf(mx, x[q][i]);
    mx = xhalf_max(mx);
    const float m_new = fmaxf(m_run, mx), alpha = FEXP2(m_run - m_new);
    float ps = 0.f;
#pragma unroll
    for (int q = 0; q < 2; ++q) {
#pragma unroll
        for (int i = 0; i < 16; ++i) { x[q][i] = FEXP2(x[q][i] - m_new); ps += x[q][i]; }
        pf[q][0] = pack8f(x[q], 0); pf[q][1] = pack8f(x[q], 1);
    }
    l_run = l_run * alpha + ps; m_run = m_new;
#pragma unroll
    for (int dt = 0; dt < 4; ++dt)
#pragma unroll
        for (int i = 0; i < 16; ++i) o[dt][i] *= alpha;
}
__device__ __forceinline__ void pv_x(const bf16x8 (&pf)[2][2], f32x16 (&o)[4], const LAS unsigned char* tbuf  , int r, int hh) {
#pragma unroll
    for (int q = 0; q < 2; ++q) {
        const LAS unsigned char* vb = tbuf + KT_BYTES + (32 * q + 4 * hh) * 2;
        bf16x8 vf[4][2];
#pragma unroll
        for (int dt = 0; dt < 4; ++dt) { vf[dt][0] = ldfrag2(vb + (32 * dt + r) * VP); vf[dt][1] = ldfrag2(vb + (32 * dt + r) * VP + 32); }
        SCHED_BAR(); SETPRIO(1);
#pragma unroll
        for (int dt = 0; dt < 4; ++dt) { o[dt] = mfma32(vf[dt][0], pf[q][0], o[dt]); o[dt] = mfma32(vf[dt][1], pf[q][1], o[dt]); }
        SETPRIO(0); SCHED_BAR();
    }
}

__device__ __forceinline__ void diff_attn_job(LAS unsigned char* lds, const int wave_, const MixArgs& A, int b, int h, int qb) {
    int tid_j = wave_ * 64 + LANE_ID(); LAUNDER(tid_j);
    const int tid = tid_j, wave = UNIFORM(tid >> 6), lane = tid & 63;
    const int qg = wave >> 1, map = wave & 1;
    const int tq = 128 * qb + 32 * qg + (lane & 31);
    bf16x8 qf[4];
#pragma unroll
    for (int s = 0; s < 4; ++s) qf[s] = *(const bf16x8*)(A.U + ((size_t)b * T + tq) * ULD + U_DQ + h * 128 + map * 64 + 16 * s + 8 * (lane >> 5));
    const float c1 = 0.125f * LOG2E, c2 = LOG2E * (h == 0 ? 0.25f : h == 1 ? 0.0625f : h == 2 ? 0.015625f : 0.00390625f);
    const int npair = qb + 1;
    f32x16 o[4]; o[0] = zero16(); o[1] = zero16(); o[2] = zero16(); o[3] = zero16();
    float m_run = -1e30f, l_run = 0.f;
    const bf16* kb0 = A.U + (size_t)b * T * ULD + U_DK + h * 128; const bf16* vb0 = A.VT + (size_t)(V_D + h * 128) * M + (size_t)b * T;
    StageRegs Rk, Rv;
    stage_load_k(Rk, kb0, tid); stage_load_v(Rv, vb0, tid);
    for (int p = 0; p < npair; ++p) {
        int lane_ = lane, tid_ = tid; LAUNDER(lane_); LAUNDER(tid_);
        const int r = lane_ & 31, hh = lane_ >> 5;
        LAS unsigned char* buf = lds + (p & 1) * 2 * STG;
        const bool more = p + 1 < npair, diag = (p == npair - 1);
        stage_store_k(Rk, buf, tid_); stage_store_v(Rv, buf, tid_);
        __syncthreads();
        if (more) { stage_load_k(Rk, kb0 + (size_t)(128 * (p + 1)) * ULD, tid_); stage_load_v(Rv, vb0 + 128 * (p + 1), tid_); }
#pragma unroll
        for (int tt = 0; tt < 2; ++tt) {
            const LAS unsigned char* tb = buf + tt * STG;
            if (!(tt == 1 && diag && qg < 2)) {
                f32x16 x[2]; x[0] = zero16(); x[1] = zero16();
                { bf16x8 kf[4][2];
#pragma unroll
                  for (int s = 0; s < 4; ++s) { kf[s][0] = ldfrag(tb + r * KP + map * 128 + s * 32 + hh * 16); kf[s][1] = ldfrag(tb + (32 + r) * KP + map * 128 + s * 32 + hh * 16); }
                  SCHED_BAR(); SETPRIO(1);
#pragma unroll
                  for (int s = 0; s < 4; ++s) { x[0] = mfma32(kf[s][0], qf[s], x[0]); x[1] = mfma32(kf[s][1], qf[s], x[1]); }
                  SETPRIO(0); SCHED_BAR(); }
                if (!diag) {
                    float c2l = c2; LAUNDER(c2l);
                    const float base = -c2l * (float)(tq - 128 * p - 64 * tt - 4 * hh), te1 = c2l, te2 = 2.f * c2l, te3 = 3.f * c2l;
#pragma unroll
                    for (int q = 0; q < 2; ++q)
#pragma unroll
                        for (int g = 0; g < 4; ++g) { const float bg = base + c2l * (float)(32 * q + 8 * g);
                            x[q][4 * g] = x[q][4 * g] * c1 + bg; x[q][4 * g + 1] = x[q][4 * g + 1] * c1 + (bg + te1); x[q][4 * g + 2] = x[q][4 * g + 2] * c1 + (bg + te2); x[q][4 * g + 3] = x[q][4 * g + 3] * c1 + (bg + te3); }
                } else {
                    const int dk0 = tq - (128 * p + 64 * tt + 4 * hh);
#pragma unroll
                    for (int q = 0; q < 2; ++q)
#pragma unroll
                        for (int i = 0; i < 16; ++i) x[q][i] = x[q][i] * c1 - c2 * fabsf((float)(dk0 - (32 * q + (i & 3) + 8 * (i >> 2))));
                }
                bf16x8 pf[2][2];
                softmax_x(x, m_run, l_run, o, pf);
                pv_x(pf, o, tb, r, hh);
            }
        }
    }
    __syncthreads();
    l_run += __shfl_xor(l_run, 32);
    const float inv_l = FRCP(l_run);
    LAS float* EX = (LAS float*)lds;
    int lane_e = lane; LAUNDER(lane_e);
    const int lane_x = lane_e;
    if (map == 1) {
#pragma unroll
        for (int dt = 0; dt < 4; ++dt)
#pragma unroll
            for (int i = 0; i < 16; ++i) EX[(qg * 64 + dt * 16 + i) * 64 + lane_x] = o[dt][i] * inv_l;
    }
    __syncthreads();
    if (map == 0) {
        const int hh = lane_x >> 5;
        float s01 = A.diff_lambda[lane_x] * A.diff_lambda[64 + lane_x], s23 = A.diff_lambda[128 + lane_x] * A.diff_lambda[192 + lane_x];
#pragma unroll
        for (int o_ = 1; o_ < 64; o_ <<= 1) { s01 += __shfl_xor(s01, o_); s23 += __shfl_xor(s23, o_); }
        const float lam_full = FEXP(s01) - FEXP(s23) + A.lam_init;
        float ss = 0.f;
#pragma unroll
        for (int dt = 0; dt < 4; ++dt)
#pragma unroll
            for (int i = 0; i < 16; ++i) { const float v = o[dt][i] * inv_l - lam_full * EX[(qg * 64 + dt * 16 + i) * 64 + lane_x]; o[dt][i] = v; ss += v * v; }
        ss += __shfl_xor(ss, 32);
        const float sc = FRSQRT(ss * (1.0f / 128.0f) + 1e-6f) * (1.0f - A.lam_init);
        bf16* orow = A.BR + ((size_t)b * T + 128 * qb + 32 * qg + (lane_x & 31)) * 2048 + h * 128;
#pragma unroll
        for (int dt = 0; dt < 4; ++dt)
#pragma unroll
            for (int g = 0; g < 4; ++g) { const int d = 32 * dt + 8 * g + 4 * hh; const f32x4 gn = *(const f32x4*)(A.diff_norm + h * 128 + d);
                *(u32x2*)(orow + d) = pack4(o[dt][4 * g] * sc * gn[0], o[dt][4 * g + 1] * sc * gn[1], o[dt][4 * g + 2] * sc * gn[2], o[dt][4 * g + 3] * sc * gn[3]); }
    }
    __syncthreads();
}

__device__ __forceinline__ void band_attn_job(LAS unsigned char* lds, const int wave_, const MixArgs& A, int b, int h, int cg) {
    int tid_j = wave_ * 64 + LANE_ID(); LAUNDER(tid_j);
    const int tid = tid_j, wave = UNIFORM(tid >> 6), lane = tid & 63;
    const int cq = 4 * cg + (wave >> 1), tq = 64 * cq + 32 * (wave & 1) + (lane & 31);
    LAS float* TAB = (LAS float*)(lds + 4 * STG);
    if (tid < 257) TAB[tid] = A.rel_bias[h * 257 + tid] * LOG2E;
    bf16x8 qf[8];
#pragma unroll
    for (int s = 0; s < 8; ++s) qf[s] = *(const bf16x8*)(A.U + ((size_t)b * T + tq) * ULD + U_CQ + h * 128 + 16 * s + 8 * (lane >> 5));
    const float c1 = 0.08838834764831845f * LOG2E;
    const int ck0 = (4 * cg - 8 > 0) ? 4 * cg - 8 : 0, npair = (4 * cg + 4 - ck0) >> 1;
    f32x16 o[4]; o[0] = zero16(); o[1] = zero16(); o[2] = zero16(); o[3] = zero16();
    float m_run = -1e30f, l_run = 0.f;
    const bf16* kb0 = A.U + ((size_t)b * T + 64 * ck0) * ULD + U_CK + h * 128; const bf16* vb0 = A.VT + (size_t)(V_C + h * 128) * M + (size_t)b * T + 64 * ck0;
    StageRegs Rk, Rv;
    stage_load_k(Rk, kb0, tid); stage_load_v(Rv, vb0, tid);
    for (int p = 0; p < npair; ++p) {
        int lane_ = lane, tid_ = tid; LAUNDER(lane_); LAUNDER(tid_);
        const int r = lane_ & 31, hh = lane_ >> 5;
        LAS unsigned char* buf = lds + (p & 1) * 2 * STG;
        const bool more = p + 1 < npair;
        stage_store_k(Rk, buf, tid_); stage_store_v(Rv, buf, tid_);
        __syncthreads();
        if (more) { stage_load_k(Rk, kb0 + (size_t)(128 * (p + 1)) * ULD, tid_); stage_load_v(Rv, vb0 + 128 * (p + 1), tid_); }
#pragma unroll
        for (int tt = 0; tt < 2; ++tt) {
            const LAS unsigned char* tb = buf + tt * STG;
            const int ck = ck0 + 2 * p + tt; const bool act = (ck <= cq && ck >= cq - 8);
            f32x16 x[2]; bf16x8 pf[2][2];
            if (act) {
                x[0] = zero16(); x[1] = zero16();
#pragma unroll
                for (int sh = 0; sh < 2; ++sh) { bf16x8 kf[4][2];
#pragma unroll
                  for (int s = 0; s < 4; ++s) { kf[s][0] = ldfrag(tb + r * KP + (4 * sh + s) * 32 + hh * 16); kf[s][1] = ldfrag(tb + (32 + r) * KP + (4 * sh + s) * 32 + hh * 16); }
                  SCHED_BAR(); SETPRIO(1);
#pragma unroll
                  for (int s = 0; s < 4; ++s) { x[0] = mfma32(kf[s][0], qf[4 * sh + s], x[0]); x[1] = mfma32(kf[s][1], qf[4 * sh + s], x[1]); }
                  SETPRIO(0); SCHED_BAR(); }
                if (cq - ck >= 3) {
                    const float bias = TAB[256];
#pragma unroll
                    for (int q = 0; q < 2; ++q)
#pragma unroll
                        for (int i = 0; i < 16; ++i) x[q][i] = x[q][i] * c1 + bias;
                } else {
                    const int dk0 = tq - (64 * ck + 4 * hh);
#pragma unroll
                    for (int q = 0; q < 2; ++q)
#pragma unroll
                        for (int i = 0; i < 16; ++i) { int rel = dk0 - (32 * q + (i & 3) + 8 * (i >> 2)); rel = rel < -128 ? -128 : (rel > 128 ? 128 : rel); x[q][i] = x[q][i] * c1 + TAB[rel + 128]; }
                }
                softmax_x(x, m_run, l_run, o, pf);
            }
            if (act) pv_x(pf, o, tb, r, hh);
        }
    }
    l_run += __shfl_xor(l_run, 32);
    int lane_e = lane; LAUNDER(lane_e);
    const float inv_l = FRCP(l_run); const int hh = lane_e >> 5;
    bf16* orow = A.BR + ((size_t)b * T + 64 * cq + 32 * (wave & 1) + (lane_e & 31)) * 2048 + 3 * 512 + h * 128;
#pragma unroll
    for (int dt = 0; dt < 4; ++dt)
#pragma unroll
        for (int g = 0; g < 4; ++g) { const int d = 32 * dt + 8 * g + 4 * hh;
            *(u32x2*)(orow + d) = pack4(o[dt][4 * g] * inv_l, o[dt][4 * g + 1] * inv_l, o[dt][4 * g + 2] * inv_l, o[dt][4 * g + 3] * inv_l); }
    __syncthreads();
}

constexpr int GP = 144;
constexpr int G_QR = 0, G_KR = 8192, G_GL = 16384, G_WGU = 18432, G_BG = 22528, G_SEG = 22784, G_ETOT = 24832, G_QD = 25088, G_KI = G_QD + 64 * GP, G_KTT = G_KI + 64 * GP,
              G_VTI = G_KTT + 64 * GP, G_STI = G_VTI + 128 * GP, G_ATT = G_STI + 128 * GP, G_SSQ = G_ATT + 64 * GP, G_GAIN = G_SSQ + 1024, G_END = G_GAIN + 512;
struct GlaRegs { u32x4 q, k, gl, v[2]; };
__device__ __forceinline__ void gla_load(GlaRegs& R, const MixArgs& A, int b, int h, int c, int tid) {
    const size_t m0 = (size_t)b * T + 64 * c;
    R.q = *(const u32x4*)(A.U + (m0 + (tid >> 3)) * ULD + U_GQ + h * 64 + (tid & 7) * 8);
    R.k = *(const u32x4*)(A.U + (m0 + (tid >> 3)) * ULD + U_GK + h * 64 + (tid & 7) * 8);
    if (tid < 128) R.gl = *(const u32x4*)(A.U + (m0 + (tid >> 1)) * ULD + U_GL + (tid & 1) * 8);
#pragma unroll
    for (int i = 0; i < 2; ++i) { const int cc = tid + 512 * i; R.v[i] = *(const u32x4*)(A.VT + (size_t)(V_G + h * 128 + (cc >> 3)) * M + m0 + (cc & 7) * 8); }
}
constexpr int NSEG = 4, CPS = NCH / NSEG, NBH = NB * 4;
constexpr int GST = 8192 + 64, MST = 16384 + 128 + 4 + 124;
__device__ __forceinline__ float* gla_slot(const MixArgs& A, int bh, int sg) { return A.ST + (size_t)(bh * NSEG + sg) * GST; }
__device__ __forceinline__ float* ml_slot(const MixArgs& A, int bh, int sg) { return A.ST + (size_t)NBH * NSEG * GST + (size_t)(bh * NSEG + sg) * MST; }
__device__ __forceinline__ void gla_job(LAS unsigned char* lds, const int wave_, const MixArgs& A, int b, int h, int sg, int mode) {
    int tid_j = wave_ * 64 + LANE_ID(); LAUNDER(tid_j);
    const int tid0 = tid_j, wave = UNIFORM(tid0 >> 6), lane0 = tid0 & 63;
    const int seg = wave;
    const int ki = wave >> 2, ni = wave & 3;
    LAS float* WGU = (LAS float*)(lds + G_WGU); LAS float* BG = (LAS float*)(lds + G_BG); LAS float* SEG = (LAS float*)(lds + G_SEG); LAS float* ETOT = (LAS float*)(lds + G_ETOT);
    LAS float* SSQ = (LAS float*)(lds + G_SSQ); LAS float* GAIN = (LAS float*)(lds + G_GAIN);
    for (int i = tid0; i < 1024; i += 512) WGU[i] = A.gla_wgu[(i >> 6) * 256 + h * 64 + (i & 63)];
    if (tid0 < 64) BG[tid0] = A.gla_bg[h * 64 + tid0];
    if (tid0 < 128) GAIN[tid0] = A.gla_norm[h * 128 + tid0];
    f32x16 S = zero16();
    const int c0 = sg * CPS, c1 = c0 + CPS;
    float dseg = 1.f;
    const bool outs = (mode != 1), keep = (mode != 3);
    if (mode == 3) {
        for (int sp = 0; sp < sg; ++sp) {
            int lane = lane0; LAUNDER(lane); const int hh = lane >> 5;
            const float* slot = gla_slot(A, b * 4 + h, sp);
            __syncthreads();
            if (tid0 < 64) ETOT[tid0] = slot[8192 + tid0];
            __syncthreads();
#pragma unroll
            for (int g = 0; g < 4; ++g) { const f32x4 e = *(const LAS f32x4*)(ETOT + 32 * ki + 8 * g + 4 * hh); S[4 * g] *= e[0]; S[4 * g + 1] *= e[1]; S[4 * g + 2] *= e[2]; S[4 * g + 3] *= e[3]; }
#pragma unroll
            for (int i = 0; i < 16; ++i) S[i] += slot[(wave * 16 + i) * 64 + lane];
        }
        __syncthreads();
    }
    GlaRegs R; gla_load(R, A, b, h, c0, tid0);
    for (int c = c0; c < c1; ++c) {
        int lane = lane0, tid = tid0; LAUNDER(lane); LAUNDER(tid);
        const int r = lane & 31, hh = lane >> 5, j = lane;
        *(LAS u32x4*)(lds + G_QR + (tid >> 3) * 128 + (tid & 7) * 16) = R.q;
        *(LAS u32x4*)(lds + G_KR + (tid >> 3) * 128 + (tid & 7) * 16) = R.k;
        if (tid < 128) *(LAS u32x4*)(lds + G_GL + (tid >> 1) * 32 + (tid & 1) * 16) = R.gl;
#pragma unroll
        for (int i = 0; i < 2; ++i) { const int cc = tid + 512 * i; *(LAS u32x4*)(lds + G_VTI + (cc >> 3) * GP + (cc & 7) * 16) = R.v[i]; }
        __syncthreads();
        if (c + 1 < c1) gla_load(R, A, b, h, c + 1, tid);
        u32x2 rgate[4];
#pragma unroll
        for (int g = 0; g < 4; ++g) { rgate[g].x = 0u; rgate[g].y = 0u; if (outs) rgate[g] = *(const u32x2*)(A.U + ((size_t)b * T + 64 * c + 32 * ki + r) * ULD + U_GR + h * 128 + 32 * ni + 8 * g + 4 * hh); }
        float cl[8]; float run = 0.f;
#pragma unroll
        for (int tt = 0; tt < 8; ++tt) { const int t = 8 * seg + tt; float d = BG[j];
#pragma unroll
            for (int i = 0; i < 16; ++i) d += bf2f(((const LAS bf16*)(lds + G_GL))[t * 16 + i]) * WGU[i * 64 + j];
            run += flogsig(d) * (1.0f / 16.0f); cl[tt] = run; }
        SEG[seg * 64 + j] = run;
        __syncthreads();
        { float off = 0.f, tot = 0.f;
#pragma unroll
          for (int s2 = 0; s2 < 8; ++s2) { const float v = SEG[s2 * 64 + j]; tot += v; if (s2 < seg) off += v; }
          if (seg == 0) { const float et = FEXP(tot); ETOT[j] = et; dseg *= et; }
#pragma unroll
          for (int tt = 0; tt < 8; ++tt) { const int t = 8 * seg + tt; const float cum = cl[tt] + off;
              const float qv = bf2f(((const LAS bf16*)(lds + G_QR))[t * 64 + j]), kv = bf2f(((const LAS bf16*)(lds + G_KR))[t * 64 + j]);
              if (outs) { *(LAS bf16*)(lds + G_QD + t * GP + j * 2) = (bf16)f2bf(qv * 0.125f * FEXP(cum));
                               *(LAS bf16*)(lds + G_KI + t * GP + j * 2) = (bf16)f2bf(kv * FEXP(-cum)); }
              *(LAS bf16*)(lds + G_KTT + j * GP + t * 2) = (bf16)f2bf(kv * FEXP(tot - cum)); }
          if (outs) {
#pragma unroll
            for (int g = 0; g < 4; ++g) *(LAS u32x2*)(lds + G_STI + (32 * ni + r) * GP + (32 * ki + 8 * g + 4 * hh) * 2) = pack4(S[4 * g], S[4 * g + 1], S[4 * g + 2], S[4 * g + 3]); }
        }
        __syncthreads();
        {
#pragma unroll
            for (int g = 0; g < 4; ++g) { const f32x4 e = *(const LAS f32x4*)(ETOT + 32 * ki + 8 * g + 4 * hh); S[4 * g] *= e[0]; S[4 * g + 1] *= e[1]; S[4 * g + 2] *= e[2]; S[4 * g + 3] *= e[3]; }
#pragma unroll
            for (int s = 0; s < 4; ++s) S = mfma32(ldfrag(lds + G_KTT + (32 * ki + r) * GP + s * 32 + hh * 16), ldfrag(lds + G_VTI + (32 * ni + r) * GP + s * 32 + hh * 16), S);
            if (wave < 4 && outs) {
                const int si = wave >> 1, ti = wave & 1; f32x16 x = zero16();
                if (si <= ti) {
#pragma unroll
                    for (int s = 0; s < 4; ++s) x = mfma32(ldfrag(lds + G_KI + (32 * si + r) * GP + s * 32 + hh * 16), ldfrag(lds + G_QD + (32 * ti + r) * GP + s * 32 + hh * 16), x);
                }
                const int t = 32 * ti + r;
#pragma unroll
                for (int i = 0; i < 16; ++i) { const int s_ = 32 * si + (i & 3) + 8 * (i >> 2) + 4 * hh; if (s_ > t) x[i] = 0.f; }
#pragma unroll
                for (int g = 0; g < 4; ++g) *(LAS u32x2*)(lds + G_ATT + t * GP + (32 * si + 8 * g + 4 * hh) * 2) = pack4(x[4 * g], x[4 * g + 1], x[4 * g + 2], x[4 * g + 3]);
            }
        }
        __syncthreads();
        if (!outs) continue;
        const int ti = ki, t = 32 * ti + r;
        f32x16 o = zero16();
#pragma unroll
        for (int s = 0; s < 4; ++s) o = mfma32(ldfrag(lds + G_VTI + (32 * ni + r) * GP + s * 32 + hh * 16), ldfrag(lds + G_ATT + t * GP + s * 32 + hh * 16), o);
#pragma unroll
        for (int s = 0; s < 4; ++s) o = mfma32(ldfrag(lds + G_STI + (32 * ni + r) * GP + s * 32 + hh * 16), ldfrag(lds + G_QD + t * GP + s * 32 + hh * 16), o);
        { float ss = 0.f;
#pragma unroll
          for (int i = 0; i < 16; ++i) ss += o[i] * o[i];
          ss += __shfl_xor(ss, 32);
          if (hh == 0) SSQ[ni * 64 + t] = ss; }
        __syncthreads();
        { const float rstd = FRSQRT((SSQ[t] + SSQ[64 + t] + SSQ[128 + t] + SSQ[192 + t]) * (1.0f / 128.0f) + 1e-6f);
          const size_t mrow = (size_t)b * T + 64 * c + t;
#pragma unroll
          for (int g = 0; g < 4; ++g) { const int dv = 32 * ni + 8 * g + 4 * hh; const u32x2 rr = rgate[g];
              const float r0 = bf2f(rr.x & 0xffffu), r1 = bf2f(rr.x >> 16), r2 = bf2f(rr.y & 0xffffu), r3 = bf2f(rr.y >> 16);
              *(u32x2*)(A.BR + mrow * 2048 + 512 + h * 128 + dv) = pack4(o[4 * g] * rstd * GAIN[dv] * r0 * fsigmoid(r0), o[4 * g + 1] * rstd * GAIN[dv + 1] * r1 * fsigmoid(r1),
                                                                                   o[4 * g + 2] * rstd * GAIN[dv + 2] * r2 * fsigmoid(r2), o[4 * g + 3] * rstd * GAIN[dv + 3] * r3 * fsigmoid(r3)); }
        }
    }
    if (keep) {
        float* slot = gla_slot(A, b * 4 + h, sg);
#pragma unroll
        for (int i = 0; i < 16; ++i) slot[(wave * 16 + i) * 64 + lane0] = S[i];
        if (seg == 0) slot[8192 + lane0] = dseg;
    }
    __syncthreads();
}

constexpr int MP = 272;
constexpr int L_QR = 0, L_KR = 67 * MP, L_QI = 0, L_QW = 64 * MP, L_KI = 128 * MP, L_KWT = 192 * MP, L_VTI = L_KWT + 128 * GP, L_CTI = L_VTI + 128 * GP, L_AW = L_CTI + 128 * MP,
              L_SM = L_AW + 64 * GP;
constexpr int F_LI = 0, F_LF = 64, F_BC = 128, F_GG = 192, F_MT = 256, F_IW = 320, F_KW = 384, F_DEN = 448, F_QN = 576, F_SSQ = 640, F_NS = 896, F_CW = 1152, F_CB = 2176, F_GAIN = 2432, F_SC = 2560, F_END = 2576;
struct MlRegs { u32x4 q[3], k[3], v[2]; unsigned ip, fp; };
__device__ __forceinline__ void ml_load(MlRegs& R, const MixArgs& A, int b, int h, int c, int tid) {
    const size_t m0 = (size_t)b * T + 64 * c;
#pragma unroll
    for (int i = 0; i < 3; ++i) { const int cc = tid + 512 * i; const int row = cc >> 4, t = 64 * c + row - 3; unsigned z0 = 0u; LAUNDER(z0); u32x4 z; z.x = z.y = z.z = z.w = z0; R.q[i] = z; R.k[i] = z;
        if (row < 67 && t >= 0) { const bf16* p = A.U + ((size_t)b * T + t) * ULD + h * 128 + (cc & 15) * 8; R.q[i] = *(const u32x4*)(p + U_MQ); R.k[i] = *(const u32x4*)(p + U_MK); } }
#pragma unroll
    for (int i = 0; i < 2; ++i) { const int cc = tid + 512 * i; R.v[i] = *(const u32x4*)(A.VT + (size_t)(V_M + h * 128 + (cc >> 3)) * M + m0 + (cc & 7) * 8); }
    if (tid < 64) { R.ip = A.U[(m0 + tid) * ULD + U_MI + h]; R.fp = A.U[(m0 + tid) * ULD + U_MF + h]; }
}
__device__ __forceinline__ void mlstm_job(LAS unsigned char* lds, const int wave_, const MixArgs& A, int b, int h, int sg, int mode) {
    int tid_j = wave_ * 64 + LANE_ID(); LAUNDER(tid_j);
    const int tid0 = tid_j, wave = UNIFORM(tid0 >> 6), lane0 = tid0 & 63;
    const int ni = wave & 3, kq = wave >> 2;
    LAS float* F = (LAS float*)(lds + L_SM);
    for (int i = tid0; i < 1024; i += 512) { const int qk = i >> 9, jj = (i >> 7) & 3, d = i & 127; F[F_CW + i] = A.conv_w[jj * 1024 + qk * 512 + h * 128 + d]; }
    if (tid0 < 256) F[F_CB + tid0] = A.conv_b[(tid0 >> 7) * 512 + h * 128 + (tid0 & 127)];
    if (tid0 < 128) F[F_GAIN + tid0] = A.ml_norm[h * 128 + tid0];
    if (tid0 < 256) F[F_NS + tid0] = 0.f;
    const float bi = A.b_i[h], bfv = A.b_f[h];
    f32x16 C0 = zero16(), C1 = zero16();
    const bool outs = (mode != 1), keep = (mode != 3);
    float m_prev = (mode == 1) ? -1e30f : 0.f, gsum = 0.f;
    const int c0 = sg * CPS, c1 = c0 + CPS;
    if (mode == 3) {
        __syncthreads();
        for (int sp = 0; sp < sg; ++sp) {
            const float* slot = ml_slot(A, b * 4 + h, sp);
            const float mloc = slot[16384 + 128], G = slot[16384 + 129];
            const float m_out = fmaxf(G + m_prev, mloc), a = FEXP(G + m_prev - m_out), bsc = FEXP(mloc - m_out);
#pragma unroll
            for (int i = 0; i < 16; ++i) { C0[i] = a * C0[i] + bsc * slot[(wave * 32 + i) * 64 + lane0]; C1[i] = a * C1[i] + bsc * slot[(wave * 32 + 16 + i) * 64 + lane0]; }
            if (tid0 < 128) F[F_NS + tid0] = a * F[F_NS + tid0] + bsc * slot[16384 + tid0];
            m_prev = m_out;
        }
        __syncthreads();
    }
    MlRegs R; ml_load(R, A, b, h, c0, tid0);
    for (int c = c0; c < c1; ++c) {
        const int cur = c & 1, nxt = cur ^ 1;
        int lane = lane0, tid = tid0; LAUNDER(lane); LAUNDER(tid);
        const int r = lane & 31, hh = lane >> 5;
#pragma unroll
        for (int i = 0; i < 3; ++i) { const int cc = tid + 512 * i; const int row = cc >> 4; if (row < 67) { *(LAS u32x4*)(lds + L_QR + row * MP + (cc & 15) * 16) = R.q[i]; *(LAS u32x4*)(lds + L_KR + row * MP + (cc & 15) * 16) = R.k[i]; } }
#pragma unroll
        for (int i = 0; i < 2; ++i) { const int cc = tid + 512 * i; *(LAS u32x4*)(lds + L_VTI + (cc >> 3) * GP + (cc & 7) * 16) = R.v[i]; }
        if (tid < 64) { F[F_LI + tid] = bf2f(R.ip) + bi; F[F_LF + tid] = flogsig(bf2f(R.fp) + bfv); }
        __syncthreads();
        u32x2 ogate[4];
#pragma unroll
        for (int g = 0; g < 4; ++g) { ogate[g].x = 0u; ogate[g].y = 0u; if (outs) ogate[g] = *(const u32x2*)(A.U + ((size_t)b * T + 64 * c + 32 * kq + r) * ULD + U_MO + h * 128 + 32 * ni + 8 * g + 4 * hh); }
        if (wave == 0) {
            float bc = F[F_LF + lane];
#pragma unroll
            for (int d = 1; d < 64; d <<= 1) { const float v = __shfl_up(bc, d); if (lane >= d) bc += v; }
            const float btot = __shfl(bc, 63);
            const float li = F[F_LI + lane], g = li - bc;
            float pm = g;
#pragma unroll
            for (int d = 1; d < 64; d <<= 1) { const float v = __shfl_up(pm, d); if (lane >= d) pm = fmaxf(pm, v); }
            const float m_loc = btot + __shfl(pm, 63);
            const float mt = fmaxf(bc + pm, bc + m_prev), m_new = fmaxf(btot + m_prev, m_loc);
            F[F_BC + lane] = bc; F[F_GG + lane] = g; F[F_MT + lane] = mt; F[F_IW + lane] = FEXP(bc + m_prev - mt); F[F_KW + lane] = FEXP(btot + g - m_new);
            if (lane == 0) { F[F_SC] = m_new; F[F_SC + 1] = FEXP(btot + m_prev - m_new); }
            gsum += btot;
        }
        const int d8 = tid & 15, t2 = tid >> 4;
        float qv[2][8], kv[2][8];
#define ML_CONV(dst, RAW, CWO, CBO, SCL) do { \
    _Pragma("unroll") for (int u = 0; u < 2; ++u) _Pragma("unroll") for (int e = 0; e < 8; ++e) dst[u][e] = F[(CBO) + 8 * d8 + e]; \
    _Pragma("unroll") for (int jj = 0; jj < 4; ++jj) { float w8[8]; _Pragma("unroll") for (int e = 0; e < 8; ++e) w8[e] = F[(CWO) + jj * 128 + 8 * d8 + e]; \
        _Pragma("unroll") for (int u = 0; u < 2; ++u) { const u32x4 xx = *(const LAS u32x4*)(lds + (RAW) + (t2 + 32 * u + jj) * MP + d8 * 16); const unsigned xw[4] = {xx.x, xx.y, xx.z, xx.w}; \
            _Pragma("unroll") for (int e = 0; e < 8; ++e) dst[u][e] += w8[e] * bf2f((e & 1) ? (xw[e >> 1] >> 16) : (xw[e >> 1] & 0xffffu)); } } \
    _Pragma("unroll") for (int u = 0; u < 2; ++u) _Pragma("unroll") for (int e = 0; e < 8; ++e) dst[u][e] = dst[u][e] * fsigmoid(dst[u][e]) * (SCL); } while (0)
        if (outs) ML_CONV(qv, L_QR, F_CW, F_CB, 1.0f);
        CFENCE();
        ML_CONV(kv, L_KR, F_CW + 512, F_CB + 128, 0.08838834764831845f);
#undef ML_CONV
        __syncthreads();
        const float m_new = F[F_SC], adec = F[F_SC + 1];
#pragma unroll
        for (int u = 0; u < 2; ++u) { const int t = t2 + 32 * u; const float iw = F[F_IW + t], kw = F[F_KW + t];
            u32x4 w;
            if (outs) {
            w.x = pk2(qv[u][0], qv[u][1]); w.y = pk2(qv[u][2], qv[u][3]); w.z = pk2(qv[u][4], qv[u][5]); w.w = pk2(qv[u][6], qv[u][7]); *(LAS u32x4*)(lds + L_QI + t * MP + d8 * 16) = w;
            w.x = pk2(qv[u][0] * iw, qv[u][1] * iw); w.y = pk2(qv[u][2] * iw, qv[u][3] * iw); w.z = pk2(qv[u][4] * iw, qv[u][5] * iw); w.w = pk2(qv[u][6] * iw, qv[u][7] * iw); *(LAS u32x4*)(lds + L_QW + t * MP + d8 * 16) = w;
            w.x = pk2(kv[u][0], kv[u][1]); w.y = pk2(kv[u][2], kv[u][3]); w.z = pk2(kv[u][4], kv[u][5]); w.w = pk2(kv[u][6], kv[u][7]); *(LAS u32x4*)(lds + L_KI + t * MP + d8 * 16) = w;
            }
#pragma unroll
            for (int e = 0; e < 8; ++e) *(LAS bf16*)(lds + L_KWT + (8 * d8 + e) * GP + t * 2) = (bf16)f2bf(kv[u][e] * kw); }
#pragma unroll
        for (int g = 0; g < 4; ++g) { if (!outs) break;
            *(LAS u32x2*)(lds + L_CTI + (32 * ni + r) * MP + (64 * kq + 8 * g + 4 * hh) * 2) = pack4(C0[4 * g], C0[4 * g + 1], C0[4 * g + 2], C0[4 * g + 3]);
            *(LAS u32x2*)(lds + L_CTI + (32 * ni + r) * MP + (64 * kq + 32 + 8 * g + 4 * hh) * 2) = pack4(C1[4 * g], C1[4 * g + 1], C1[4 * g + 2], C1[4 * g + 3]); }
        __syncthreads();
#pragma unroll
        for (int i = 0; i < 16; ++i) { C0[i] *= adec; C1[i] *= adec; }
#pragma unroll
        for (int s = 0; s < 4; ++s) { const bf16x8 bv = ldfrag(lds + L_VTI + (32 * ni + r) * GP + s * 32 + hh * 16);
            C0 = mfma32(ldfrag(lds + L_KWT + (64 * kq + r) * GP + s * 32 + hh * 16), bv, C0); C1 = mfma32(ldfrag(lds + L_KWT + (64 * kq + 32 + r) * GP + s * 32 + hh * 16), bv, C1); if (s & 1) SCHED_BAR(); }
        if (wave < 4) { if (outs) {
            const int si = wave >> 1, ti = wave & 1, t = 32 * ti + r; f32x16 x = zero16();
            if (si <= ti) {
#pragma unroll
                for (int s = 0; s < 8; ++s) { x = mfma32(ldfrag(lds + L_KI + (32 * si + r) * MP + s * 32 + hh * 16), ldfrag(lds + L_QI + t * MP + s * 32 + hh * 16), x); if ((s & 3) == 3) SCHED_BAR(); }
            }
            const float bt = F[F_BC + t] - F[F_MT + t]; float dsum = 0.f;
#pragma unroll
            for (int g = 0; g < 4; ++g) { const f32x4 gg = *(const LAS f32x4*)(F + F_GG + 32 * si + 8 * g + 4 * hh);
#pragma unroll
                for (int e = 0; e < 4; ++e) { const int s_ = 32 * si + 8 * g + 4 * hh + e; const float wgt = (s_ <= t) ? FEXP(bt + gg[e]) : 0.f; x[4 * g + e] *= wgt; dsum += x[4 * g + e]; }
                *(LAS u32x2*)(lds + L_AW + t * GP + (32 * si + 8 * g + 4 * hh) * 2) = pack4(x[4 * g], x[4 * g + 1], x[4 * g + 2], x[4 * g + 3]); }
            dsum += __shfl_xor(dsum, 32);
            if (hh == 0) F[F_DEN + si * 64 + t] = dsum; }
        } else if (wave < 6) {
            const int d = tid - 256; float dn0 = 0.f, dn1 = 0.f;
#pragma unroll
            for (int c8 = 0; c8 < 8; ++c8) { const u32x4 w = *(const LAS u32x4*)(lds + L_KWT + d * GP + c8 * 16);
                dn0 += (bf2f(w.x & 0xffffu) + bf2f(w.x >> 16)) + (bf2f(w.y & 0xffffu) + bf2f(w.y >> 16)); dn1 += (bf2f(w.z & 0xffffu) + bf2f(w.z >> 16)) + (bf2f(w.w & 0xffffu) + bf2f(w.w >> 16)); }
            F[F_NS + nxt * 128 + d] = adec * F[F_NS + cur * 128 + d] + (dn0 + dn1);
        } else if (wave == 6 && outs) {
            const int t = tid - 384; float q0 = 0.f, q1 = 0.f;
#pragma unroll
            for (int c8 = 0; c8 < 16; ++c8) { const u32x4 w = *(const LAS u32x4*)(lds + L_QI + t * MP + c8 * 16);
                const f32x4 n0 = *(const LAS f32x4*)(F + F_NS + cur * 128 + 8 * c8), n1 = *(const LAS f32x4*)(F + F_NS + cur * 128 + 8 * c8 + 4);
                q0 += (bf2f(w.x & 0xffffu) * n0[0] + bf2f(w.x >> 16) * n0[1]) + (bf2f(w.y & 0xffffu) * n0[2] + bf2f(w.y >> 16) * n0[3]);
                q1 += (bf2f(w.z & 0xffffu) * n1[0] + bf2f(w.z >> 16) * n1[1]) + (bf2f(w.w & 0xffffu) * n1[2] + bf2f(w.w >> 16) * n1[3]); }
            F[F_QN + t] = q0 + q1;
        }
        __syncthreads();
        if (c + 1 < c1) ml_load(R, A, b, h, c + 1, tid);
        if (!outs) { m_prev = m_new; continue; }
        const int t = 32 * kq + r;
        f32x16 o = zero16();
#pragma unroll
        for (int s = 0; s < 4; ++s) o = mfma32(ldfrag(lds + L_VTI + (32 * ni + r) * GP + s * 32 + hh * 16), ldfrag(lds + L_AW + t * GP + s * 32 + hh * 16), o);
        SCHED_BAR();
#pragma unroll
        for (int s = 0; s < 8; ++s) { o = mfma32(ldfrag(lds + L_CTI + (32 * ni + r) * MP + s * 32 + hh * 16), ldfrag(lds + L_QW + t * MP + s * 32 + hh * 16), o); if ((s & 3) == 3) SCHED_BAR(); }
        const size_t mrow = (size_t)b * T + 64 * c + t;
        { const float den = F[F_DEN + t] + F[F_DEN + 64 + t] + F[F_IW + t] * F[F_QN + t];
          const float inv = FRCP(fmaxf(fabsf(den), FEXP(-F[F_MT + t]))); float ss = 0.f;
#pragma unroll
          for (int g = 0; g < 4; ++g) { const int dv = 32 * ni + 8 * g + 4 * hh; const u32x2 oo = ogate[g];
              const float g0 = fsigmoid(bf2f(oo.x & 0xffffu)), g1 = fsigmoid(bf2f(oo.x >> 16)), g2 = fsigmoid(bf2f(oo.y & 0xffffu)), g3 = fsigmoid(bf2f(oo.y >> 16));
              o[4 * g] *= inv * g0; o[4 * g + 1] *= inv * g1; o[4 * g + 2] *= inv * g2; o[4 * g + 3] *= inv * g3;
              ss += o[4 * g] * o[4 * g] + o[4 * g + 1] * o[4 * g + 1] + o[4 * g + 2] * o[4 * g + 2] + o[4 * g + 3] * o[4 * g + 3]; }
          ss += __shfl_xor(ss, 32);
          if (hh == 0) F[F_SSQ + ni * 64 + t] = ss; }
        __syncthreads();
        { const float rstd = FRSQRT((F[F_SSQ + t] + F[F_SSQ + 64 + t] + F[F_SSQ + 128 + t] + F[F_SSQ + 192 + t]) * (1.0f / 128.0f) + 1e-6f);
#pragma unroll
          for (int g = 0; g < 4; ++g) { const int dv = 32 * ni + 8 * g + 4 * hh;
              *(u32x2*)(A.BR + mrow * 2048 + 2 * 512 + h * 128 + dv) = pack4(o[4 * g] * rstd * F[F_GAIN + dv], o[4 * g + 1] * rstd * F[F_GAIN + dv + 1], o[4 * g + 2] * rstd * F[F_GAIN + dv + 2], o[4 * g + 3] * rstd * F[F_GAIN + dv + 3]); }
        }
        m_prev = m_new;
    }
    if (keep) {
        float* slot = ml_slot(A, b * 4 + h, sg);
#pragma unroll
        for (int i = 0; i < 16; ++i) { slot[(wave * 32 + i) * 64 + lane0] = C0[i]; slot[(wave * 32 + 16 + i) * 64 + lane0] = C1[i]; }
        if (tid0 < 128) slot[16384 + tid0] = F[F_NS + (c1 & 1) * 128 + tid0];
        if (tid0 == 0) { slot[16384 + 128] = m_prev; slot[16384 + 129] = (mode == 2) ? -1e30f : gsum; }
    }
    __syncthreads();
}

constexpr int NJ_SA = 2 * NBH * (NSEG - 1), NJ_SB = 2 * NBH * NSEG, NJ_DIFF = (T / 128) * NB * 4, NJ_BAND = (NCH / 4) * NB * 4;
constexpr int MIX_JOBWORD = 152 * 1024 - 64;
#ifndef JOB_MASK
#define JOB_MASK 15
#endif
#define MIX_LEADER() (WAVE_ID() == 0 && LANE_ID() == 0)
#define MIX_FIRST(CNT, JQ) do { __syncthreads();   if (MIX_LEADER()) *(volatile LAS unsigned*)(lds + MIX_JOBWORD) = atomicAdd((CNT), 1u); __syncthreads(); JQ = (int)*(volatile LAS unsigned*)(lds + MIX_JOBWORD); __syncthreads(); } while (0)
#define MIX_RANGE(CNT, JQ, START, END, BODY) while (JQ < (END)) { { const int job = JQ - (START); BODY; } \
        if (MIX_LEADER()) *(volatile LAS unsigned*)(lds + MIX_JOBWORD) = atomicAdd((CNT), 1u);     \
        __syncthreads(); JQ = (int)*(volatile LAS unsigned*)(lds + MIX_JOBWORD); }
constexpr int NJ_DIFF_A = ((T / 128) * 18 / 32) * NB * 4;
constexpr int JA0 = 0, JA1 = JA0 + NBH, JA2 = JA1 + NBH * (NSEG - 2), JA3 = JA2 + NBH, JA4 = JA3 + NBH * (NSEG - 2), JA5 = JA4 + NJ_DIFF_A, JA6 = JA5 + NJ_BAND;
constexpr int JB0 = 0, JB1 = JB0 + NBH * (NSEG - 1), JB2 = JB1 + NBH * (NSEG - 1), JB3 = JB2 + (NJ_DIFF - NJ_DIFF_A);
#ifndef PG8_ALIGN
#define PG8_ALIGN 1
#endif
#ifndef PG8_SP2
#define PG8_SP2 1
#endif
typedef int i32x4_t __attribute__((ext_vector_type(4)));
typedef int i32x8_t __attribute__((ext_vector_type(8)));
__device__ __forceinline__ unsigned pk4_fp8(float a, float b, float c, float d) {
    a = fminf(fmaxf(a, -448.f), 448.f); b = fminf(fmaxf(b, -448.f), 448.f); c = fminf(fmaxf(c, -448.f), 448.f); d = fminf(fmaxf(d, -448.f), 448.f);
    int w = __builtin_amdgcn_cvt_pk_fp8_f32(a, b, 0, false); w = __builtin_amdgcn_cvt_pk_fp8_f32(c, d, w, true); return (unsigned)w;
}
constexpr float NL2E = -1.4426950408889634f;
constexpr float F8_SC_HID = 4.f;
constexpr float F8_SC_H = 8.f, F8_SC_W = 512.f, F8_DESCALE = 1.f / (8.f * 512.f);
#ifndef PG8_FORCE8
#define PG8_FORCE8 0
#endif
namespace pg8 {
constexpr int BM = 256, BK = 64, HALF = 128, HTB = HALF * BK * 2, STAGE_BYTES = 8 * HTB, NXCD = 8, WGM = 8;
__host__ __device__ __forceinline__ int lds_byte(int r, int c) { const int st = (r >> 4) * 2 + (c >> 5), rr = r & 15, cc = c & 31, ob = rr * 64 + cc * 2; return st * 1024 + (ob ^ (((ob >> 9) & 1) << 5)); }
__host__ __device__ __forceinline__ void stage_rc(int b, int& R, int& C) { const int st = b / 1024, sb = b % 1024, swz = sb ^ (((sb >> 9) & 1) << 5); R = (st >> 1) * 16 + swz / 64; C = (st & 1) * 32 + (swz % 64) / 2; }
__host__ __device__ __forceinline__ int perm32(int rho) { const int n = rho >> 4, i = rho & 15; return 8 * (i >> 2) + 4 * n + (i & 3); }

struct Unit { const char* a; const char* b; int pm, pn, kind, nt; };

__device__ __forceinline__ void tile_of(int L, int nM, int nN, int& pm, int& pn) {
    const int nwg = nM * nN; int wgid = L; { const int q = nwg / NXCD, r = nwg % NXCD, xcd = wgid % NXCD, off = wgid / NXCD; wgid = (xcd < r ? xcd * (q + 1) : r * (q + 1) + (xcd - r) * q) + off; }
    const int nig = WGM * nN, gid = wgid / nig, fm = gid * WGM, gsz = (nM - fm) < WGM ? (nM - fm) : WGM;
    pm = fm + ((wgid % nig) % gsz); pn = (wgid % nig) / gsz;
}

template <bool MIX8 = false, class Epi, class Sched>
__device__ __forceinline__ void gemm_phase(LAS unsigned char* lds, const int wave_, const int K  , const Sched& S, const Epi& E) {
    int tid_l = wave_ * 64 + LANE_ID(); LAUNDER(tid_l);
    const int tid = tid_l, wid = __builtin_amdgcn_readfirstlane(tid >> 6), lane = tid & 63, wr = wid >> 2, wc = wid & 3, fr = lane & 15, fq = lane >> 4;
    unsigned voffA[2], voffB[2];
#pragma unroll
    for (int i = 0; i < 2; ++i) { int R, C; stage_rc(tid * 16 + i * 8192, R, C); const int Rb = Epi::PERM ? ((R & ~31) + perm32(R & 31)) : R;
        voffA[i] = (unsigned)(R * K + C) * 2u; voffB[i] = (unsigned)(Rb * K + C) * 2u; }
    const size_t kstep = (size_t)(BK * 2);
    const size_t hstep = (size_t)HALF * K * 2;
    const unsigned ldsw = (unsigned)wid * 1024u;
    const int aoff = lds_byte(wr * 64 + fr, fq * 8), boff = lds_byte(wc * 32 + fr, fq * 8);
#define PG8_SA(b, h) (((b) * 2 + (h)) * HTB)
#define PG8_SB(b, h) ((4 + (b) * 2 + (h)) * HTB)
#define PG8_STAGE(bufoff, gbase, voff) do { _Pragma("unroll") for (int _i = 0; _i < 2; ++_i) \
        __builtin_amdgcn_global_load_lds((const unsigned*)((const char*)(gbase) + (voff)[_i]), (LAS unsigned*)(lds + (bufoff) + ldsw + _i * 8192), 16, 0, 0); } while (0)
#define PG8_LDA(dst, b, h) do { _Pragma("unroll") for (int m = 0; m < 4; ++m) _Pragma("unroll") for (int k = 0; k < 2; ++k) dst[m][k] = *(const LAS bf16x8*)(lds + PG8_SA(b, h) + aoff + m * 2048 + k * 1024); } while (0)
#define PG8_LDB(dst, b, h) do { _Pragma("unroll") for (int n = 0; n < 2; ++n) _Pragma("unroll") for (int k = 0; k < 2; ++k) dst[n][k] = *(const LAS bf16x8*)(lds + PG8_SB(b, h) + boff + n * 2048 + k * 1024); } while (0)
#define PG8_CAT8(x0, x1) __builtin_shufflevector(__builtin_bit_cast(i32x4_t, x0), __builtin_bit_cast(i32x4_t, x1), 0, 1, 2, 3, 4, 5, 6, 7)
#define PG8_MMA16(ai, bj, At, Bt) do { __builtin_amdgcn_s_setprio(1); _Pragma("unroll") for (int m = 0; m < 4; ++m) _Pragma("unroll") for (int n = 0; n < 2; ++n) _Pragma("unroll") for (int k = 0; k < 2; ++k) \
        acc[ai][bj][m][n] = __builtin_amdgcn_mfma_f32_16x16x32_bf16(Bt[n][k], At[m][k], acc[ai][bj][m][n], 0, 0, 0); __builtin_amdgcn_s_setprio(0); } while (0)
#define PG8_MMA8(ai, bj, At, Bt) do { __builtin_amdgcn_s_setprio(1); _Pragma("unroll") for (int m = 0; m < 4; ++m) _Pragma("unroll") for (int n = 0; n < 2; ++n) { \
        const i32x8_t _a = PG8_CAT8(Bt[n][0], Bt[n][1]), _b = PG8_CAT8(At[m][0], At[m][1]); \
        asm volatile("v_mfma_f32_16x16x128_f8f6f4 %0, %1, %2, %0" : "+v"(acc[ai][bj][m][n]) : "v"(_a), "v"(_b)); } __builtin_amdgcn_s_setprio(0); } while (0)
#define PG8_MFMA_DRAIN asm volatile("s_nop 15\n\ts_nop 15\n\ts_nop 7" ::: "memory")
#define PG8_WAIT_V(n) asm volatile("s_waitcnt vmcnt(" #n ")" ::: "memory")
#define PG8_WAIT_L(n) asm volatile("s_waitcnt lgkmcnt(" #n ")" ::: "memory")
#define PG8_BAR __builtin_amdgcn_s_barrier()
#define PG8_SCHED __builtin_amdgcn_sched_barrier(0)
    Unit cur, nxt; int ui = 0;
    if (!S.next(0, cur)) return;
    f32x4 acc[2][2][4][2];
    float z0 = 0.f; LAUNDER(z0);
#pragma unroll
    for (int a = 0; a < 2; ++a)
#pragma unroll
        for (int b = 0; b < 2; ++b)
#pragma unroll
            for (int m = 0; m < 4; ++m)
#pragma unroll
                for (int n = 0; n < 2; ++n) acc[a][b][m][n] = (f32x4){z0, z0, z0, z0};
    bf16x8 At[4][2], B0[2][2], B1[2][2];
    const char* cA = cur.a; const char* cB = cur.b;
    bool c8 = MIX8 && (cur.kind & 1);
    PG8_STAGE(PG8_SB(0, 0), cB, voffB); PG8_STAGE(PG8_SB(0, 1), cB + hstep, voffB); PG8_STAGE(PG8_SA(0, 0), cA, voffA); PG8_STAGE(PG8_SA(0, 1), cA + hstep, voffA);
    if (wr == 1) PG8_BAR;
    PG8_WAIT_V(2); PG8_BAR;
    PG8_STAGE(PG8_SB(1, 0), cB + kstep, voffB); PG8_STAGE(PG8_SA(1, 0), cA + kstep, voffA); PG8_STAGE(PG8_SB(1, 1), cB + hstep + kstep, voffB);
    PG8_WAIT_V(6); PG8_BAR;
    for (;;) {
        const bool has_next = S.next(ui + 1, nxt);
        const char* nA = has_next ? nxt.a : cA; const char* nB = has_next ? nxt.b : cB;
        const int nt = cur.nt;
        const bool n8 = MIX8 && ((has_next ? nxt.kind : cur.kind) & 1);
#define PG8_KLOOP(MMA) \
        for (int t = 0; t < nt; t += 2) { \
            const bool last = (t == nt - 2); \
            const char* a1 = cA + (size_t)(t + 1) * kstep; \
            const char* a2 = last ? nA : cA + (size_t)(t + 2) * kstep; const char* b2 = last ? nB : cB + (size_t)(t + 2) * kstep; \
            const char* a3 = a2 + kstep; const char* b3 = b2 + kstep; \
            PG8_LDB(B0, 0, 0); PG8_LDB(B1, 0, 1); PG8_SCHED; PG8_LDA(At, 0, 0); PG8_STAGE(PG8_SA(1, 1), a1 + hstep, voffA); \
            PG8_WAIT_V(8); PG8_WAIT_L(0); PG8_BAR; MMA(0, 0, At, B0); MMA(0, 1, At, B1); PG8_BAR; PG8_SCHED; \
            PG8_LDA(At, 0, 1); PG8_STAGE(PG8_SB(0, 0), b2, voffB); PG8_STAGE(PG8_SB(0, 1), b2 + hstep, voffB); PG8_STAGE(PG8_SA(0, 0), a2, voffA); \
            PG8_WAIT_V(8); PG8_WAIT_L(0); PG8_BAR; MMA(1, 0, At, B0); MMA(1, 1, At, B1); PG8_BAR; PG8_SCHED; \
            PG8_LDB(B0, 1, 0); PG8_LDB(B1, 1, 1); PG8_SCHED; PG8_LDA(At, 1, 0); PG8_STAGE(PG8_SA(0, 1), a2 + hstep, voffA); \
            PG8_WAIT_V(8); PG8_WAIT_L(0); PG8_BAR; MMA(0, 0, At, B0); MMA(0, 1, At, B1); PG8_BAR; PG8_SCHED; \
            PG8_LDA(At, 1, 1); PG8_STAGE(PG8_SB(1, 0), b3, voffB); PG8_STAGE(PG8_SB(1, 1), b3 + hstep, voffB); PG8_STAGE(PG8_SA(1, 0), a3, voffA); \
            PG8_WAIT_V(8); PG8_WAIT_L(0); PG8_BAR; MMA(1, 0, At, B0); MMA(1, 1, At, B1); PG8_BAR; PG8_SCHED; \
        }
        if (MIX8) { int c8l = __builtin_amdgcn_readfirstlane(c8 ? 1 : 0); asm volatile("" : "+s"(c8l));
            if (PG8_FORCE8 || c8l) { PG8_KLOOP(PG8_MMA8) PG8_MFMA_DRAIN; } else { PG8_KLOOP(PG8_MMA16) } }
        else { PG8_KLOOP(PG8_MMA16) }
#undef PG8_KLOOP
#if PG8_ALIGN
        if (wr == 0) PG8_BAR;
#endif
        if (MIX8) { int kl = __builtin_amdgcn_readfirstlane(cur.kind); asm volatile("" : "+s"(kl)); cur.kind = kl; }
        E(acc, cur, wr, wc, fr, fq);
        if (!has_next) break;
#pragma unroll
        for (int a = 0; a < 2; ++a)
#pragma unroll
            for (int b = 0; b < 2; ++b)
#pragma unroll
                for (int m = 0; m < 4; ++m)
#pragma unroll
                    for (int n = 0; n < 2; ++n) acc[a][b][m][n] = (f32x4){z0, z0, z0, z0};
        cur = nxt; cA = nA; cB = nB; ++ui; c8 = n8;
#if PG8_ALIGN
        if (wr == 1) PG8_BAR;
#endif
    }
    PG8_WAIT_V(0);
#if !PG8_ALIGN
    if (wr == 0) PG8_BAR;
#endif
    PG8_BAR;
#undef PG8_SA
#undef PG8_SB
#undef PG8_STAGE
#undef PG8_LDA
#undef PG8_LDB
#undef PG8_MMA16
#undef PG8_MMA8
#undef PG8_MFMA_DRAIN
#undef PG8_CAT8
#undef PG8_WAIT_V
#undef PG8_WAIT_L
#undef PG8_BAR
#undef PG8_SCHED
}

__device__ __forceinline__ unsigned cvt_pk_bf16(float lo, float hi) { return pk2(lo, hi); }

template <int ACT  , bool F8OUT = false  > struct EpiBf {
    static constexpr bool PERM = true;
    bf16* O0; int ld0; bf16* O1; int ld1;
    float osc;
    const float* rs;
    __device__ __forceinline__ void operator()(const f32x4 (&acc)[2][2][4][2], const Unit& u, int wr, int wc, int fr, int fq) const {
        bf16* base = u.kind ? O1 : O0; const int ldc = u.kind ? ld1 : ld0;
        int frl = fr, fql = fq; LAUNDER(frl); LAUNDER(fql);
        const int row0 = u.pm * BM + wr * 64 + frl, col0 = u.pn * BM + wc * 32 + 8 * fql;
        f32x4 cs[2][2];
        if (rs && u.kind) {
#pragma unroll
            for (int bj = 0; bj < 2; ++bj) { cs[bj][0] = *(const f32x4*)(rs + col0 + bj * HALF); cs[bj][1] = *(const f32x4*)(rs + col0 + bj * HALF + 4); } }
        float rrv[2][4];
#pragma unroll
        for (int ai = 0; ai < 2; ++ai)
#pragma unroll
            for (int m = 0; m < 4; ++m) rrv[ai][m] = (rs && !u.kind) ? rs[row0 + ai * HALF + m * 16] : osc;
#pragma unroll
        for (int ai = 0; ai < 2; ++ai)
#pragma unroll
            for (int m = 0; m < 4; ++m) { bf16* rowp = base + (size_t)(row0 + ai * HALF + m * 16) * ldc + col0;
                const float rr = rrv[ai][m];
#pragma unroll
                for (int bj = 0; bj < 2; ++bj) { f32x4 v0 = acc[ai][bj][m][0], v1 = acc[ai][bj][m][1];
                    if (rs && u.kind) { v0 = v0 * cs[bj][0]; v1 = v1 * cs[bj][1]; } else if (rs || osc != 1.f) { v0 = v0 * rr; v1 = v1 * rr; }
                    if (ACT == 1) {
#pragma unroll
                        for (int j = 0; j < 4; ++j) { const float a = fmaxf(v0[j], 0.f), b = fmaxf(v1[j], 0.f); v0[j] = a * a; v1[j] = b * b; } }
                    if (F8OUT) { u32x2 w8; w8.x = pk4_fp8(v0[0] * F8_SC_HID, v0[1] * F8_SC_HID, v0[2] * F8_SC_HID, v0[3] * F8_SC_HID); w8.y = pk4_fp8(v1[0] * F8_SC_HID, v1[1] * F8_SC_HID, v1[2] * F8_SC_HID, v1[3] * F8_SC_HID);
                        *(u32x2*)((unsigned char*)base + (size_t)(row0 + ai * HALF + m * 16) * ldc + col0 + bj * HALF) = w8; }
                    else { u32x4 w; w.x = cvt_pk_bf16(v0[0], v0[1]); w.y = cvt_pk_bf16(v0[2], v0[3]); w.z = cvt_pk_bf16(v1[0], v1[1]); w.w = cvt_pk_bf16(v1[2], v1[3]);
                    *(u32x4*)(rowp + bj * HALF) = w; } } }
    }
};
struct EpiF32 {
    static constexpr bool PERM = false;
    float* C; int ldc;
    __device__ __forceinline__ void operator()(const f32x4 (&acc)[2][2][4][2], const Unit& u, int wr, int wc, int fr, int fq) const {
        const int row0 = u.pm * BM + wr * 64 + fr, col0 = u.pn * BM + wc * 32 + 4 * fq;
#pragma unroll
        for (int ai = 0; ai < 2; ++ai)
#pragma unroll
            for (int m = 0; m < 4; ++m) { float* rowp = C + (size_t)(row0 + ai * HALF + m * 16) * ldc + col0;
#pragma unroll
                for (int bj = 0; bj < 2; ++bj)
#pragma unroll
                    for (int n = 0; n < 2; ++n) *(f32x4*)(rowp + bj * HALF + n * 16) = acc[ai][bj][m][n]; }
    }
};
struct EpiGateFused {
    static constexpr bool PERM = true;
    u32x4* PS; u32x4* MS; bf16* MG; const float* bias;
    __device__ __forceinline__ void operator()(const f32x4 (&acc)[2][2][4][2], const Unit& u, int wr, int wc, int fr, int fq) const {
        int frl = fr, fql = fq; LAUNDER(frl); LAUNDER(fql);
        const int bi = u.kind >> 1; const int lt = (wr * 4 + wc) * 64 + fql * 16 + frl;
        if (!(u.kind & 1)) {
#pragma unroll
            for (int ai = 0; ai < 2; ++ai)
#pragma unroll
                for (int m = 0; m < 4; ++m)
#pragma unroll
                    for (int bj = 0; bj < 2; ++bj) { const f32x4 v0 = acc[ai][bj][m][0], v1 = acc[ai][bj][m][1];
                        u32x4 w; w.x = cvt_pk_bf16(v0[0], v0[1]); w.y = cvt_pk_bf16(v0[2], v0[3]); w.z = cvt_pk_bf16(v1[0], v1[1]); w.w = cvt_pk_bf16(v1[2], v1[3]);
                        PS[((ai * 4 + m) * 2 + bj) * 512 + lt] = w; }
            return;
        }
        const int row0 = u.pm * BM + wr * 64 + frl, col0 = u.pn * BM + wc * 32 + 8 * fql;
        f32x4 bv[2][2];
#pragma unroll
        for (int bj = 0; bj < 2; ++bj)
#pragma unroll
            for (int n = 0; n < 2; ++n) bv[bj][n] = *(const f32x4*)(bias + bi * 2048 + col0 + bj * HALF + 4 * n) * NL2E;
        u32x4 pvv[2][2][2], ovv[2][2][2];
#define GF_LOAD(g) do { _Pragma("unroll") for (int ml = 0; ml < 2; ++ml) _Pragma("unroll") for (int bj = 0; bj < 2; ++bj) { const int si = (((g) * 2 + ml) * 2 + bj) * 512 + lt; \
            pvv[(g) & 1][ml][bj] = PS[si]; if (bi > 0) ovv[(g) & 1][ml][bj] = MS[si]; else ovv[(g) & 1][ml][bj] = pvv[(g) & 1][ml][bj]; } } while (0)
        GF_LOAD(0);
#pragma unroll
        for (int g = 0; g < 4; ++g) {
            const int ai = g >> 1, mh = g & 1;
            u32x4 wres[2][2];
#pragma unroll
            for (int ml = 0; ml < 2; ++ml)
#pragma unroll
                for (int bj = 0; bj < 2; ++bj) {
                    const int m = 2 * mh + ml;
                    const u32x4 pv = pvv[g & 1][ml][bj];
                    const f32x4 a0 = acc[ai][bj][m][0] * (F8_DESCALE * NL2E) + bv[bj][0], a1 = acc[ai][bj][m][1] * (F8_DESCALE * NL2E) + bv[bj][1];
                    f32x4 e0, e1;
#pragma unroll
                    for (int j = 0; j < 4; ++j) { e0[j] = __builtin_amdgcn_exp2f(a0[j]); e1[j] = __builtin_amdgcn_exp2f(a1[j]); }
                    const f32x4 d0 = e0 + 1.0f, d1 = e1 + 1.0f;
                    float v[8]; const unsigned pw[4] = {pv.x, pv.y, pv.z, pv.w};
#pragma unroll
                    for (int j = 0; j < 4; ++j) { v[j] = bf2f(j & 1 ? pw[j >> 1] >> 16 : pw[j >> 1] & 0xffffu) * FRCP(d0[j]); v[4 + j] = bf2f(j & 1 ? pw[2 + (j >> 1)] >> 16 : pw[2 + (j >> 1)] & 0xffffu) * FRCP(d1[j]); }
                    if (bi > 0) { const u32x4 ov = ovv[g & 1][ml][bj]; const unsigned ow[4] = {ov.x, ov.y, ov.z, ov.w};
#pragma unroll
                        for (int j = 0; j < 8; ++j) v[j] += bf2f(j & 1 ? ow[j >> 1] >> 16 : ow[j >> 1] & 0xffffu); }
                    u32x4 w; w.x = cvt_pk_bf16(v[0], v[1]); w.y = cvt_pk_bf16(v[2], v[3]); w.z = cvt_pk_bf16(v[4], v[5]); w.w = cvt_pk_bf16(v[6], v[7]);
                    wres[ml][bj] = w; }
            asm volatile("" ::: "memory");
            if (g == 0) GF_LOAD(1);
            if (g == 1) GF_LOAD(2);
            if (g == 2) GF_LOAD(3);
            asm volatile("" ::: "memory");
#pragma unroll
            for (int ml = 0; ml < 2; ++ml)
#pragma unroll
                for (int bj = 0; bj < 2; ++bj) { const int m = 2 * mh + ml; const int si = ((ai * 4 + m) * 2 + bj) * 512 + lt;
                    if (bi < 3) MS[si] = wres[ml][bj];
                    else *(u32x4*)(MG + (size_t)(row0 + ai * HALF + m * 16) * 2048 + col0 + bj * HALF) = wres[ml][bj]; }
            asm volatile("" ::: "memory");
        }
#undef GF_LOAD
    }
};

struct OrdPlain {
    const char* A; const char* B; size_t ta, tb, a_grp_stride; int nM, nN, a_grp_shift, G, c, nt, kind = 0;
    __device__ __forceinline__ bool next(int i, Unit& u) const {
        const long L = (long)i * G + c; if (L >= (long)nM * nN) return false;
        int pm, pn; tile_of((int)L, nM, nN, pm, pn); u.pm = pm; u.pn = pn; u.kind = kind; u.nt = nt;
        u.a = A + (size_t)pm * ta + (size_t)(pn >> a_grp_shift) * a_grp_stride; u.b = B + (size_t)pn * tb; return true;
    }
};
struct OrdInProj {
    const char* Hb; const char* Wb; size_t th; int G, c;
    __device__ __forceinline__ bool next(int i, Unit& u) const {
        const long L = (long)i * G + c; if (L >= 128L * 27) return false;
        int pm, pn; tile_of((int)L, 128, 27, pm, pn); u.nt = 32;
        if (pn < 19) { u.pm = pm; u.pn = pn; u.kind = 0; u.a = Hb + (size_t)pm * th; u.b = Wb + (size_t)pn * th; }
        else { u.pm = pn - 19; u.pn = pm; u.kind = 1; u.a = Wb + (size_t)pn * th; u.b = Hb + (size_t)pm * th; }
        return true;
    }
};
struct OrdGateFused {
    const char* Hb; const char* Wg; const char* BRb; const char* Wb; int G, c;
    __device__ __forceinline__ bool next(int i, Unit& u) const {
        const long L = (long)(i >> 3) * G + c; if (L >= 128L * 8) return false;
        int pm, pn; tile_of((int)L, 128, 8, pm, pn); const int bi = (i >> 1) & 3, isG = i & 1; const size_t th = (size_t)256 * 2048 * 2;
        u.pm = pm; u.pn = pn; u.kind = 2 * bi + isG;
        if (isG) { u.nt = 16; u.a = Hb + (size_t)pm * th; u.b = Wg + (size_t)(bi * 8 + pn) * th; }
        else { u.nt = 8; u.a = BRb + (size_t)pm * th + (size_t)bi * 1024; u.b = Wb + (size_t)pn * th + (size_t)bi * 1024; }
        return true;
    }
};
}
constexpr size_t MiB = 1u << 20;
constexpr size_t WS_CTL = 0, CTL_ZERO_BYTES = 1 * MiB;
constexpr size_t WS_WIN = 2 * MiB, WS_WG = 29 * MiB, WS_WB = 61 * MiB, WS_WO = 69 * MiB, WS_WUP = 77 * MiB, WS_WDN = 109 * MiB;
constexpr size_t WS_H = 142 * MiB;
constexpr size_t WS_BR = 270 * MiB;
constexpr size_t WS_U = 398 * MiB;
constexpr size_t WS_VT = 702 * MiB;
constexpr size_t WS_P = 398 * MiB;
constexpr size_t WS_Y = 398 * MiB;
constexpr size_t WS_HID = 398 * MiB;
constexpr size_t WS_MG = 910 * MiB;
constexpr size_t WS_Y2 = 910 * MiB;
constexpr size_t WS_H8 = 1038 * MiB;
constexpr size_t WS_XB = 1166 * MiB;
constexpr size_t WS_END = 1294 * MiB;
static_assert(WS_U + (size_t)M * ULD * 2 <= WS_VT && WS_VT + (size_t)2048 * M * 2 <= WS_MG && WS_P + (size_t)M * 8192 * 2 <= WS_MG && WS_Y2 + (size_t)M * 2048 * 4 <= WS_XB && WS_XB + (size_t)M * 2048 * 2 <= WS_END, "ws map");
static_assert(WS_WIN + (size_t)6912 * 2048 * 2 <= WS_WG && WS_WDN + (size_t)2048 * 8192 * 2 <= WS_H && WS_H + (size_t)M * 2048 * 2 <= WS_BR && WS_BR + (size_t)4 * M * 512 * 2 <= WS_U, "ws map 2");
constexpr size_t WS_RS = 1 * MiB;
constexpr int CW_TMO = 0, CW_BAR = 4096, CW_JOB = 16384;
constexpr int LDS_BYTES = 152 * 1024, MISC_OFF = MIX_JOBWORD;
constexpr int F8_DOWN_LAYER = DEPTH - 1;
constexpr int NWAVES = 8, NPH = 9 * DEPTH + 1;

#define XB_TMO      128
#define XB_XCNT(j)  (256  + 64 * (j))
#define XB_XSUB(j)  (1280 + 64 * (j))
#define XB_XGEN(j)  (2304 + 64 * (j))
#define XB_TOP      3328
#define XB_TOPGEN   3392
#define XCD_BAR_WORDS 3456
#define XB_SPIN_CAP (1u << 18)
__device__ __forceinline__ unsigned xb_ld(unsigned* p)              { return __hip_atomic_load(p, __ATOMIC_RELAXED, __HIP_MEMORY_SCOPE_AGENT); }
__device__ __forceinline__ unsigned xb_add(unsigned* p, unsigned v) { return __hip_atomic_fetch_add(p, v, __ATOMIC_RELAXED, __HIP_MEMORY_SCOPE_AGENT); }
__device__ __forceinline__ unsigned xb_xcc_id() { return (unsigned)__builtin_amdgcn_s_getreg((3 << 11) | 20) & 0xFu; }
#define XB_SPIN(cond, bar) do { unsigned _sp = 0; while (cond) { __builtin_amdgcn_s_sleep(1); \
    if ((++_sp & 255u) == 0u) { if (xb_ld(&(bar)[XB_TMO])) break; if (_sp > XB_SPIN_CAP) { atomicAdd(&(bar)[XB_TMO], 1u); break; } } } } while (0)
struct XcdBarrier { unsigned* bar; unsigned x; volatile LAS unsigned* st; };
__device__ __forceinline__ XcdBarrier xcd_barrier_post(unsigned* bar, volatile LAS unsigned* st) {
    XcdBarrier b; b.bar = bar; b.x = xb_xcc_id(); b.st = st;
    if (threadIdx.x == 0) (void)xb_add(&bar[XB_XCNT(b.x)], 1u);
    return b;
}
__device__ __forceinline__ void xcd_barrier_complete(unsigned* bar, unsigned x, unsigned& nloc, unsigned& nx) {
    const unsigned G = gridDim.x * gridDim.y * gridDim.z;
    unsigned sum, cnt, mine, sp = 0u;
    for (;;) {
        sum = 0u; cnt = 0u; mine = 0u;
#pragma unroll
        for (unsigned j = 0; j < 16; ++j) { const unsigned c = xb_ld(&bar[XB_XCNT(j)]); sum += c; cnt += (c > 0u) ? 1u : 0u; mine = (j == x) ? c : mine; }
        if (sum == G) break;
        __builtin_amdgcn_s_sleep(1);
        if ((++sp & 255u) == 0u) { if (xb_ld(&bar[XB_TMO])) break; if (sp > XB_SPIN_CAP) { atomicAdd(&bar[XB_TMO], 1u); break; } }
    }
    nloc = mine > 0u ? mine : 1u; nx = cnt > 0u ? cnt : 1u;
}
__device__ __forceinline__ void xcd_barrier(const XcdBarrier& b, const bool leader  ) {
    asm volatile("s_waitcnt vmcnt(0)" ::: "memory");
    __syncthreads();
    if (leader) {
        unsigned* bar = b.bar;
        __builtin_amdgcn_s_waitcnt(0);
        unsigned nloc = b.st[0], nx = b.st[1];
        if (nloc == 0u) { xcd_barrier_complete(bar, b.x, nloc, nx); b.st[0] = nloc; b.st[1] = nx; }
        const unsigned old = xb_add(&bar[XB_XSUB(b.x)], 1u);
        const unsigned gen = old / nloc;
        if (old + 1u == (gen + 1u) * nloc) {
            __builtin_amdgcn_fence(__ATOMIC_RELEASE, "agent");
            asm volatile("s_waitcnt vmcnt(0)" ::: "memory");
            const unsigned og = xb_add(&bar[XB_TOP], 1u);
            const unsigned tg = og / nx;
            if (og + 1u == (tg + 1u) * nx) xb_add(&bar[XB_TOPGEN], 1u);
            else XB_SPIN(xb_ld(&bar[XB_TOPGEN]) == tg, bar);
            __builtin_amdgcn_fence(__ATOMIC_ACQUIRE, "agent");
            xb_add(&bar[XB_XGEN(b.x)], 1u);
            asm volatile("s_waitcnt vmcnt(0)" ::: "memory");
        } else {
            XB_SPIN(xb_ld(&bar[XB_XGEN(b.x)]) == gen, bar);
            __builtin_amdgcn_fence(__ATOMIC_ACQUIRE, "agent");
            asm volatile("s_waitcnt vmcnt(0)" ::: "memory");
        }
    }
    __syncthreads();
}

__device__ __forceinline__ int map_in(int n) {
    if (n < 1024) return n;
    if (n < 1536) return 4864 + (n - 1024);
    if (n < 2048) return 1024 + (n - 1536);
    if (n < 2560) return 4864 + 512 + (n - 2048);
    if (n < 2576) return 4608 + (n - 2560);
    if (n < 3088) return 1536 + (n - 2576);
    if (n < 4112) return 2048 + (n - 3088);
    if (n < 4624) return 4864 + 1024 + (n - 4112);
    if (n < 5136) return 3072 + (n - 4624);
    if (n < 5144) return 4624 + (n - 5136);
    if (n < 6168) return 3584 + (n - 5144);
    return 4864 + 1536 + (n - 6168);
}
template <bool MAPIN, bool F8 = false>
__device__ __forceinline__ void transpose_item(const float* W, int K, int N, bf16* WT, int row_off, LAS float* scr, int item, int lane, int ldw = 0  , int coff = 0, const float* gk = nullptr  ) {
    const int nblk = (N + 63) / 64, kb = item / nblk, nb = item % nblk, k0 = 64 * kb, n0 = 64 * nb;
    const bool cv = (n0 + 2 * (lane & 31)) < N;
    { float2 wv[32];
      const float* wp = W + (size_t)(k0 + (lane >> 5)) * N + n0 + 2 * (lane & 31);
#pragma unroll
      for (int i = 0; i < 32; ++i) wv[i] = cv ? *(const float2*)(wp + (size_t)(2 * i) * N) : make_float2(0.f, 0.f);
#pragma unroll
      for (int i = 0; i < 32; ++i) { LAS float* d = scr + (2 * i + (lane >> 5)) * 65 + 2 * (lane & 31); d[0] = wv[i].x; d[1] = wv[i].y; } }
    asm volatile("s_waitcnt lgkmcnt(0)" ::: "memory");
    const int c = lane & 7;
    f32x4 g0 = (f32x4){1.f, 1.f, 1.f, 1.f}, g1 = g0; if (gk) { g0 = *(const f32x4*)(gk + k0 + 8 * c); g1 = *(const f32x4*)(gk + k0 + 8 * c + 4); }
#pragma unroll
    for (int j = 0; j < 8; ++j) { const int n = (lane >> 3) + 8 * j; const LAS float* s = scr + (8 * c) * 65 + n;
        u32x4 o; o.x = pk2(s[0 * 65] * g0[0], s[1 * 65] * g0[1]); o.y = pk2(s[2 * 65] * g0[2], s[3 * 65] * g0[3]); o.z = pk2(s[4 * 65] * g1[0], s[5 * 65] * g1[1]); o.w = pk2(s[6 * 65] * g1[2], s[7 * 65] * g1[3]);
        if (F8) { u32x2 o8; o8.x = pk4_fp8(s[0 * 65] * F8_SC_W, s[1 * 65] * F8_SC_W, s[2 * 65] * F8_SC_W, s[3 * 65] * F8_SC_W); o8.y = pk4_fp8(s[4 * 65] * F8_SC_W, s[5 * 65] * F8_SC_W, s[6 * 65] * F8_SC_W, s[7 * 65] * F8_SC_W);
            if (n0 + n < N) *(u32x2*)((unsigned char*)WT + (size_t)(row_off + n0 + n) * (ldw ? ldw : 2 * K) + k0 + 8 * c) = o8; }
        else if (n0 + n < N) { const int drow = MAPIN ? map_in(n0 + n) : row_off + n0 + n; *(u32x4*)(WT + (size_t)drow * (ldw ? ldw : K) + coff + k0 + 8 * c) = o; } }
    asm volatile("s_waitcnt lgkmcnt(0)" ::: "memory");
}
struct WArgs { const float *w_in, *w_gate, *w_branch, *w_out, *w_up, *w_down; bf16 *Win_t, *Wg_t, *Wb_t, *Wo_t, *Wup_t, *Wdn_t; const float *g_in, *g_up; int dn8; };
__device__ __forceinline__ void weights_phase(LAS unsigned char* lds, const WArgs& Wa, int gw, int NGW, int wave, int lane) {
    LAS float* scr = (LAS float*)(lds + wave * 16640);
    constexpr int I_IN = 32 * 105, I_G = 32 * 32, I_B = 8 * 32, I_O = 32 * 32, I_UP = 32 * 128, I_DN = 128 * 32;
    constexpr int NITEMS = I_IN + 4 * I_G + 4 * I_B + I_O + I_UP + I_DN;
    for (int it = gw; it < NITEMS; it += NGW) {
        int r = it;
        if (r < I_IN) { transpose_item<true>(Wa.w_in, 2048, NIN, Wa.Win_t, 0, scr, r, lane, 0, 0, Wa.g_in); continue; } r -= I_IN;
        if (r < 4 * I_G) { const int bi = r / I_G; transpose_item<false, true>(Wa.w_gate + (size_t)bi * 2048 * 2048, 2048, 2048, Wa.Wg_t, bi * 2048, scr, r % I_G, lane); continue; } r -= 4 * I_G;
        if (r < 4 * I_B) { const int bi = r / I_B; transpose_item<false>(Wa.w_branch + (size_t)bi * 512 * 2048, 512, 2048, Wa.Wb_t, 0, scr, r % I_B, lane, 2048, bi * 512); continue; } r -= 4 * I_B;
        if (r < I_O) { transpose_item<false>(Wa.w_out, 2048, 2048, Wa.Wo_t, 0, scr, r, lane); continue; } r -= I_O;
        if (r < I_UP) { transpose_item<false>(Wa.w_up, 2048, 8192, Wa.Wup_t, 0, scr, r, lane, 0, 0, Wa.g_up); continue; } r -= I_UP;
        if (Wa.dn8) transpose_item<false, true>(Wa.w_down, 8192, 2048, Wa.Wdn_t, 0, scr, r, lane, 8192);
        else transpose_item<false>(Wa.w_down, 8192, 2048, Wa.Wdn_t, 0, scr, r, lane);
    }
    { unsigned z0 = 0u; LAUNDER(z0); u32x4 z; z.x = z.y = z.z = z.w = z0; u32x4* zp = (u32x4*)(Wa.Win_t + (size_t)4632 * 2048);
      for (int i = gw * 64 + lane; i < 232 * 256; i += NGW * 64) zp[i] = z; }
}

__device__ __forceinline__ float wave_sum(float v) {
#pragma unroll
    for (int o = 1; o < 64; o <<= 1) v += __shfl_xor(v, o);
    return v;
}
template <bool XIN_F32> struct NormRow;
template <> struct NormRow<true> { f32x4 xf[4][2]; u32x4 yb[4]; };
template <> struct NormRow<false> { u32x4 xb[4]; u32x4 yb[4]; };
template <bool XIN_F32>
__device__ __forceinline__ void norm_load(NormRow<XIN_F32>& R, const void* x_old_, const bf16* y, int m, int lane) {
    if constexpr (XIN_F32) { const f32x4* xr = (const f32x4*)((const float*)x_old_ + (size_t)m * D) + 2 * lane;
#pragma unroll
        for (int j = 0; j < 4; ++j) { R.xf[j][0] = xr[128 * j]; R.xf[j][1] = xr[128 * j + 1]; } }
    else { const u32x4* xr = (const u32x4*)((const bf16*)x_old_ + (size_t)m * D) + lane;
#pragma unroll
        for (int j = 0; j < 4; ++j) R.xb[j] = xr[64 * j]; }
    if (y) { const u32x4* yr = (const u32x4*)(y + (size_t)m * D) + lane;
#pragma unroll
        for (int j = 0; j < 4; ++j) R.yb[j] = yr[64 * j]; }
}
template <bool XIN_F32, bool XOUT_F32, bool H8 = false>
__device__ __forceinline__ void norm_finish(NormRow<XIN_F32>& R, const bf16* y, const f32x4 (&gp)[4][2], void* x_out_, const f32x4 (&gq)[4][2], bf16* h_out, int m, int lane, unsigned char* h8_out = nullptr, float* rs_out = nullptr) {
    f32x4 v[4][2];
#pragma unroll
    for (int j = 0; j < 4; ++j) {
        if constexpr (XIN_F32) { v[j][0] = R.xf[j][0]; v[j][1] = R.xf[j][1]; }
        else { const u32x4 t = R.xb[j]; v[j][0] = (f32x4){bf2f(t.x & 0xffffu), bf2f(t.x >> 16), bf2f(t.y & 0xffffu), bf2f(t.y >> 16)}; v[j][1] = (f32x4){bf2f(t.z & 0xffffu), bf2f(t.z >> 16), bf2f(t.w & 0xffffu), bf2f(t.w >> 16)}; }
    }
    if (y) {
        f32x4 w[4][2]; float s = 0.f;
#pragma unroll
        for (int j = 0; j < 4; ++j) { const u32x4 t = R.yb[j];
            w[j][0] = (f32x4){bf2f(t.x & 0xffffu), bf2f(t.x >> 16), bf2f(t.y & 0xffffu), bf2f(t.y >> 16)}; w[j][1] = (f32x4){bf2f(t.z & 0xffffu), bf2f(t.z >> 16), bf2f(t.w & 0xffffu), bf2f(t.w >> 16)};
#pragma unroll
            for (int k = 0; k < 2; ++k) s += (w[j][k][0] * w[j][k][0] + w[j][k][1] * w[j][k][1]) + (w[j][k][2] * w[j][k][2] + w[j][k][3] * w[j][k][3]); }
        const float rs = 1.0f / sqrtf(wave_sum(s) * (1.0f / D) + 1e-6f);
#pragma unroll
        for (int j = 0; j < 4; ++j)
#pragma unroll
            for (int k = 0; k < 2; ++k) v[j][k] = v[j][k] + w[j][k] * rs * gp[j][k];
    }
    if (x_out_) {
        if (XOUT_F32) { f32x4* xo = (f32x4*)((float*)x_out_ + (size_t)m * D) + 2 * lane;
#pragma unroll
            for (int j = 0; j < 4; ++j) { xo[128 * j] = v[j][0]; xo[128 * j + 1] = v[j][1]; } }
        else { u32x4* xo = (u32x4*)((bf16*)x_out_ + (size_t)m * D) + lane;
#pragma unroll
            for (int j = 0; j < 4; ++j) { u32x4 o; o.x = pk2(v[j][0][0], v[j][0][1]); o.y = pk2(v[j][0][2], v[j][0][3]); o.z = pk2(v[j][1][0], v[j][1][1]); o.w = pk2(v[j][1][2], v[j][1][3]); xo[64 * j] = o;
                v[j][0] = (f32x4){bf2f(o.x & 0xffffu), bf2f(o.x >> 16), bf2f(o.y & 0xffffu), bf2f(o.y >> 16)}; v[j][1] = (f32x4){bf2f(o.z & 0xffffu), bf2f(o.z >> 16), bf2f(o.w & 0xffffu), bf2f(o.w >> 16)}; } }
    }
    if (h_out || H8 || rs_out) {
        float s = 0.f;
#pragma unroll
        for (int j = 0; j < 4; ++j)
#pragma unroll
            for (int k = 0; k < 2; ++k) s += (v[j][k][0] * v[j][k][0] + v[j][k][1] * v[j][k][1]) + (v[j][k][2] * v[j][k][2] + v[j][k][3] * v[j][k][3]);
        const float rs = 1.0f / sqrtf(wave_sum(s) * (1.0f / D) + 1e-6f);
        if (rs_out && lane == 0) rs_out[m] = rs;
        if (h_out || H8) {
        u32x4* ho = (u32x4*)(h_out + (size_t)m * D) + lane;
#pragma unroll
        for (int j = 0; j < 4; ++j) { const f32x4 a = v[j][0] * rs * gq[j][0], b = v[j][1] * rs * gq[j][1]; u32x4 o; o.x = pk2(a[0], a[1]); o.y = pk2(a[2], a[3]); o.z = pk2(b[0], b[1]); o.w = pk2(b[2], b[3]); if (h_out) ho[64 * j] = o;
            if (H8) { u32x2 o8; o8.x = pk4_fp8(a[0] * F8_SC_H, a[1] * F8_SC_H, a[2] * F8_SC_H, a[3] * F8_SC_H); o8.y = pk4_fp8(b[0] * F8_SC_H, b[1] * F8_SC_H, b[2] * F8_SC_H, b[3] * F8_SC_H); ((u32x2*)(h8_out + (size_t)m * (2 * D)) + lane)[64 * j] = o8; } }
        }
    }
}
template <bool XIN_F32, bool XOUT_F32, bool H8 = false>
__device__ __forceinline__ void norm_phase(const void* x_old_, const bf16* y, const float* g_post, void* x_out_, const float* g_pre, bf16* h_out, int gw, int NGW, int lane, unsigned char* h8_out = nullptr, float* rs_out = nullptr) {
    f32x4 gp[4][2], gq[4][2]; float zf = 0.f; LAUNDER(zf);
#pragma unroll
    for (int j = 0; j < 4; ++j)
#pragma unroll
        for (int k = 0; k < 2; ++k) { gp[j][k] = y ? ((const f32x4*)g_post)[2 * lane + 128 * j + k] : (f32x4){zf, zf, zf, zf}; gq[j][k] = (h_out || H8) ? ((const f32x4*)g_pre)[2 * lane + 128 * j + k] : (f32x4){zf, zf, zf, zf}; }
    NormRow<XIN_F32> Ra, Rb;
    int m = gw;
    if (m < M) norm_load<XIN_F32>(Ra, x_old_, y, m, lane);
    for (; m < M; m += 2 * NGW) {
        const int m1 = m + NGW, m2 = m + 2 * NGW;
        if (m1 < M) norm_load<XIN_F32>(Rb, x_old_, y, m1, lane);
        norm_finish<XIN_F32, XOUT_F32, H8>(Ra, y, gp, x_out_, gq, h_out, m, lane, h8_out, rs_out);
        if (m2 < M) norm_load<XIN_F32>(Ra, x_old_, y, m2, lane);
        if (m1 < M) norm_finish<XIN_F32, XOUT_F32, H8>(Rb, y, gp, x_out_, gq, h_out, m1, lane, h8_out, rs_out);
    }
}

#ifndef PH_MASK
#define PH_MASK 0x1FF
#endif
#ifndef REP_MIX
#define REP_MIX 1
#endif
#ifndef REP_DIFF
#define REP_DIFF 1
#endif
#ifndef REP_BAND
#define REP_BAND 1
#endif
#ifndef REPJ_GLA
#define REPJ_GLA 1
#endif
#ifndef REPJ_ML
#define REPJ_ML 1
#endif
#ifndef REP_SEQ
#define REP_SEQ 1
#endif
#ifndef REP_WCONV
#define REP_WCONV 1
#endif
#ifndef REP_NORM
#define REP_NORM 1
#endif
#ifndef REP_P6
#define REP_P6 1
#endif
#ifndef REP_GEMM
#define REP_GEMM 1
#endif
#ifndef REP_G1
#define REP_G1 REP_GEMM
#endif
#ifndef REP_G3
#define REP_G3 REP_GEMM
#endif
#ifndef REP_G4
#define REP_G4 REP_GEMM
#endif
#ifndef REP_G5
#define REP_G5 REP_GEMM
#endif
#ifndef REP_G7
#define REP_G7 REP_GEMM
#endif
#ifndef REP_G8
#define REP_G8 REP_GEMM
#endif

struct Args { const float* in[23]; float* out; unsigned char* ws; float lam_init[4]; int ph_lo, ph_hi, one_launch, pad; };
typedef const __attribute__((address_space(4))) Args* CArgs;
#define PHASE_ARGS() CArgs ap = (CArgs)__builtin_amdgcn_kernarg_segment_ptr(); asm volatile("" : "+s"(ap)); unsigned char* ws = ap->ws; (void)ws; int lane = LANE_ID(); LAUNDER(lane); (void)lane; int bxl = bx; asm volatile("" : "+s"(bxl)); (void)bxl
__global__ void __launch_bounds__(NWAVES * 64, 2) fwd_kernel(Args args_unused) {
    extern __shared__ __attribute__((aligned(16))) unsigned char lds_raw[];
    LAS unsigned char* lds = (LAS unsigned char*)lds_raw;
    volatile LAS unsigned* MISC = (volatile LAS unsigned*)(lds + MISC_OFF);
    const int wave = __builtin_amdgcn_readfirstlane((int)threadIdx.x >> 6); const int g_wave_id_sgpr = wave;
    const int lane0 = LANE_ID(), tid = wave * 64 + lane0;
    const int G = gridDim.x, bx = blockIdx.x;
    const int vcu = (G % 8 == 0) ? (bx % 8) * (G / 8) + bx / 8 : bx;
    const int gw = vcu * NWAVES + wave, NGW = G * NWAVES;
    if (tid < 16) MISC[tid] = 0u;
    __syncthreads();
    int lo, hi; XcdBarrier bar;
    int ap_one_launch;
    { PHASE_ARGS(); lo = ap->ph_lo; hi = ap->ph_hi; ap_one_launch = ap->one_launch; unsigned* ctl = (unsigned*)(ws + WS_CTL); bar.bar = ctl + CW_BAR; bar.x = 0; bar.st = nullptr;
      if (ap->one_launch) bar = xcd_barrier_post(ctl + CW_BAR, MISC + 2); }
#define IN(k) (lo <= (k) && (k) < hi)
#define SEAM(k) do { if (IN((k) + 1)) xcd_barrier(bar, WAVE_ID() == 0 && LANE_ID() == 0); } while (0)
#define WSP(T_, off) ((T_*)(ws + (off)))

    for (int l = 0; l < DEPTH; ++l) {
        const int pb = 9 * l;
        if (((PH_MASK >> 0) & 1) && IN(pb + 0)) {
            PHASE_ARGS();
            WArgs Wa{ap->in[3] + (size_t)l * 2048 * NIN, ap->in[16] + (size_t)l * 4 * 2048 * 2048, ap->in[15] + (size_t)l * 4 * 512 * 2048, ap->in[18] + (size_t)l * 2048 * 2048,
                     ap->in[21] + (size_t)l * 2048 * 8192, ap->in[22] + (size_t)l * 8192 * 2048, WSP(bf16, WS_WIN), WSP(bf16, WS_WG), WSP(bf16, WS_WB), WSP(bf16, WS_WO), WSP(bf16, WS_WUP), WSP(bf16, WS_WDN), ap->in[1] + (size_t)l * D, ap->in[19] + (size_t)l * D, l == F8_DOWN_LAYER ? 1 : 0};
            for (int rep = 0; rep < REP_NORM; ++rep) {
            for (int rw = 0; rw < REP_WCONV; ++rw) weights_phase(lds, Wa, gw, NGW, wave, lane);
            if (l == 0) norm_phase<true, false, true>(ap->in[0], nullptr, nullptr, WSP(bf16, WS_XB), ap->in[1], nullptr, gw, NGW, lane, ws + WS_H8, WSP(float, WS_RS));
            else norm_phase<false, false, true>(WSP(bf16, WS_XB), WSP(bf16, WS_Y2), ap->in[20] + (size_t)(l - 1) * D, rep < REP_NORM - 1 ? WSP(bf16, WS_U) : WSP(bf16, WS_XB), ap->in[1] + (size_t)l * D, nullptr, gw, NGW, lane, ws + WS_H8, WSP(float, WS_RS));
            }
            SEAM(pb + 0);
        }
        if (((PH_MASK >> 1) & 1) && IN(pb + 1)) {
            PHASE_ARGS();
            pg8::OrdInProj S{(const char*)(ws + WS_XB), (const char*)(ws + WS_WIN), (size_t)256 * 2048 * 2, G, bxl};
            pg8::EpiBf<0> E{WSP(bf16, WS_U), ULD, WSP(bf16, WS_VT), M, 1.f, WSP(float, WS_RS)};
            for (int rep = 0; rep < REP_G1; ++rep) pg8::gemm_phase(lds, WAVE_ID(), 2048, S, E);
            SEAM(pb + 1);
        }
        if (((PH_MASK >> 2) & 1) && IN(pb + 2)) {
#define MIX_ARGS() PHASE_ARGS(); MixArgs A{}; A.U = WSP(bf16, WS_U); A.VT = WSP(bf16, WS_VT); A.BR = WSP(bf16, WS_BR); \
            A.diff_lambda = ap->in[4] + l * 256; A.diff_norm = ap->in[5] + l * 512; A.gla_wgu = ap->in[6] + l * 4096; A.gla_bg = ap->in[7] + l * 256; A.gla_norm = ap->in[8] + l * 512; \
            A.conv_w = ap->in[9] + l * 4096; A.conv_b = ap->in[10] + l * 1024; A.b_i = ap->in[11] + l * 4; A.b_f = ap->in[12] + l * 4; A.ml_norm = ap->in[13] + l * 512; A.rel_bias = ap->in[14] + l * 1028; \
            A.lam_init = ap->lam_init[l]; A.ST = WSP(float, WS_MG); unsigned* cnt = (unsigned*)(ws + WS_CTL) + CW_JOB + 256 * l + 1024 * rep
            for (int rep = 0; rep < REP_MIX; ++rep) {
            int jq;
            { MIX_ARGS(); MIX_FIRST(cnt, jq); }
            if (JOB_MASK & 2) { MIX_ARGS(); MIX_RANGE(cnt, jq, JA0, JA1, mlstm_job(lds, WAVE_ID(), A, job >> 2, job & 3, 0, 2)); }
            if (JOB_MASK & 2) { MIX_ARGS(); MIX_RANGE(cnt, jq, JA1, JA2, mlstm_job(lds, WAVE_ID(), A, (job % NBH) >> 2, job & 3, 1 + job / NBH, 1)); }
            if (JOB_MASK & 1) { MIX_ARGS(); MIX_RANGE(cnt, jq, JA2, JA3, gla_job(lds, WAVE_ID(), A, job >> 2, job & 3, 0, 2)); }
            if (JOB_MASK & 1) { MIX_ARGS(); MIX_RANGE(cnt, jq, JA3, JA4, gla_job(lds, WAVE_ID(), A, (job % NBH) >> 2, job & 3, 1 + job / NBH, 1)); }
            if (JOB_MASK & 4) { MIX_ARGS(); MIX_RANGE(cnt, jq, JA4, JA5, diff_attn_job(lds, WAVE_ID(), A, (job % NBH) >> 2, job & 3, (T / 128 - 1) - job / NBH)); }
            if (JOB_MASK & 8) { MIX_ARGS(); MIX_RANGE(cnt, jq, JA5, JA6, band_attn_job(lds, WAVE_ID(), A, (job % NBH) >> 2, job & 3, job / NBH)); }
            if (ap_one_launch) xcd_barrier(bar, WAVE_ID() == 0 && LANE_ID() == 0);
            { MIX_ARGS(); MIX_FIRST(cnt + 64, jq); }
            if (JOB_MASK & 2) { MIX_ARGS(); MIX_RANGE(cnt + 64, jq, JB0, JB1, mlstm_job(lds, WAVE_ID(), A, (job % NBH) >> 2, job & 3, 1 + job / NBH, 3)); }
            if (JOB_MASK & 1) { MIX_ARGS(); MIX_RANGE(cnt + 64, jq, JB1, JB2, gla_job(lds, WAVE_ID(), A, (job % NBH) >> 2, job & 3, 1 + job / NBH, 3)); }
            if (JOB_MASK & 4) { MIX_ARGS(); MIX_RANGE(cnt + 64, jq, JB2, JB3, diff_attn_job(lds, WAVE_ID(), A, ((job + NJ_DIFF_A) % NBH) >> 2, (job + NJ_DIFF_A) & 3, (T / 128 - 1) - (job + NJ_DIFF_A) / NBH)); }
            }
            if (IN(pb + 4)) xcd_barrier(bar, WAVE_ID() == 0 && LANE_ID() == 0);
        }
        if (((PH_MASK >> 4) & 1) && IN(pb + 4)) {
            PHASE_ARGS();
            pg8::OrdGateFused S{(const char*)(ws + WS_H8), (const char*)(ws + WS_WG), (const char*)(ws + WS_BR), (const char*)(ws + WS_WB), G, bxl};
            pg8::EpiGateFused E{(u32x4*)(ws + WS_P) + (size_t)bxl * 16384, (u32x4*)(ws + WS_P + 128 * MiB) + (size_t)bxl * 16384, WSP(bf16, WS_MG), ap->in[17] + (size_t)l * 4 * 2048};
            for (int rep = 0; rep < REP_G4; ++rep) pg8::gemm_phase<true>(lds, WAVE_ID(), 2048, S, E);
            SEAM(pb + 4);
        }
        if (((PH_MASK >> 5) & 1) && IN(pb + 5)) {
            PHASE_ARGS();
            pg8::OrdPlain S{(const char*)(ws + WS_MG), (const char*)(ws + WS_WO), (size_t)256 * 2048 * 2, (size_t)256 * 2048 * 2, 0, 128, 8, 0, G, bxl, 32};
            pg8::EpiBf<0> E{WSP(bf16, WS_Y), 2048, WSP(bf16, WS_Y), 2048, 1.f, nullptr};
            for (int rep = 0; rep < REP_G5; ++rep) pg8::gemm_phase(lds, WAVE_ID(), 2048, S, E);
            SEAM(pb + 5);
        }
        if (((PH_MASK >> 6) & 1) && IN(pb + 6)) {
            PHASE_ARGS();
            for (int rep = 0; rep < REP_P6; ++rep)
            norm_phase<false, false>(WSP(bf16, WS_XB), WSP(bf16, WS_Y), ap->in[2] + (size_t)l * D, rep < REP_P6 - 1 ? WSP(bf16, WS_BR) : WSP(bf16, WS_XB), ap->in[19] + (size_t)l * D, nullptr, gw, NGW, lane, nullptr, WSP(float, WS_RS));
            SEAM(pb + 6);
        }
        if (((PH_MASK >> 7) & 1) && IN(pb + 7)) {
            PHASE_ARGS();
            pg8::OrdPlain S{(const char*)(ws + WS_XB), (const char*)(ws + WS_WUP), (size_t)256 * 2048 * 2, (size_t)256 * 2048 * 2, 0, 128, 32, 0, G, bxl, 32};
            if (l == F8_DOWN_LAYER) { pg8::EpiBf<1, true> E{WSP(bf16, WS_HID), 8192, WSP(bf16, WS_HID), 8192, 1.f, WSP(float, WS_RS)}; pg8::gemm_phase(lds, WAVE_ID(), 2048, S, E); }
            else { pg8::EpiBf<1> E{WSP(bf16, WS_HID), 8192, WSP(bf16, WS_HID), 8192, 1.f, WSP(float, WS_RS)};
            for (int rep = 0; rep < REP_G7; ++rep) pg8::gemm_phase(lds, WAVE_ID(), 2048, S, E); }
            SEAM(pb + 7);
        }
        if (((PH_MASK >> 8) & 1) && IN(pb + 8)) {
            PHASE_ARGS();
            if (l == F8_DOWN_LAYER) {
                pg8::OrdPlain S{(const char*)(ws + WS_HID), (const char*)(ws + WS_WDN), (size_t)256 * 8192, (size_t)256 * 8192, 0, 128, 8, 0, G, bxl, 64, 1};
                pg8::EpiBf<0> E{WSP(bf16, WS_Y2), 2048, WSP(bf16, WS_Y2), 2048, 1.f / (F8_SC_HID * F8_SC_W), nullptr};
                pg8::gemm_phase<true>(lds, WAVE_ID(), 4096, S, E); }
            else {
            pg8::OrdPlain S{(const char*)(ws + WS_HID), (const char*)(ws + WS_WDN), (size_t)256 * 8192 * 2, (size_t)256 * 8192 * 2, 0, 128, 8, 0, G, bxl, 128};
            pg8::EpiBf<0> E{WSP(bf16, WS_Y2), 2048, WSP(bf16, WS_Y2), 2048, 1.f, nullptr};
            for (int rep = 0; rep < REP_G8; ++rep) pg8::gemm_phase(lds, WAVE_ID(), 8192, S, E); }
            SEAM(pb + 8);
        }
    }
    if (IN(9 * DEPTH)) { PHASE_ARGS(); norm_phase<false, true>(WSP(bf16, WS_XB), WSP(bf16, WS_Y2), ap->in[20] + (size_t)(DEPTH - 1) * D, ap->out, nullptr, nullptr, gw, NGW, lane); }
#undef IN
#undef SEAM
}

extern "C" void kernel_launch(void* const* d_in, const int* in_sizes, int n_in, void* d_out, int out_size, void* d_ws, size_t ws_size, hipStream_t stream) {
    static int grid = 0;
    if (grid == 0) {
        if (n_in != 23 || in_sizes[0] != M * D || out_size != M * D || ws_size < WS_END) { fprintf(stderr, "kernel_launch: unexpected shapes / workspace (n_in %d, ws %zu, need %zu); nothing launched\n", n_in, ws_size, (size_t)WS_END); grid = -1; return; }
        int dev = 0, cus = 0, per_cu = 0;
        if (hipGetDevice(&dev) != hipSuccess || hipDeviceGetAttribute(&cus, hipDeviceAttributeMultiprocessorCount, dev) != hipSuccess) { grid = -1; return; }
        if (hipFuncSetAttribute((const void*)fwd_kernel, hipFuncAttributeMaxDynamicSharedMemorySize, LDS_BYTES) != hipSuccess) { fprintf(stderr, "kernel_launch: hipFuncSetAttribute failed\n"); grid = -1; return; }
        if (hipOccupancyMaxActiveBlocksPerMultiprocessor(&per_cu, (const void*)fwd_kernel, NWAVES * 64, LDS_BYTES) != hipSuccess || per_cu < 1) fprintf(stderr, "kernel_launch: occupancy query reports %d\n", per_cu);
        (void)hipGetLastError();
        grid = cus;
    }
    if (grid < 0) return;
    if (hipMemsetAsync((char*)d_ws + WS_CTL, 0, CTL_ZERO_BYTES, stream) != hipSuccess) return;
    Args a{};
    for (int i = 0; i < 23; ++i) a.in[i] = (const float*)d_in[i];
    a.out = (float*)d_out; a.ws = (unsigned char*)d_ws;
    for (int l = 0; l < 4; ++l) a.lam_init[l] = (float)(0.8 - 0.6 * exp(-0.3 * (double)l));
    a.ph_lo = 0; a.ph_hi = NPH; a.one_launch = 1;
    hipLaunchKernelGGL(fwd_kernel, dim3(grid), dim3(NWAVES * 64), LDS_BYTES, stream, a);
    const hipError_t le = hipPeekAtLastError();
    if (le != hipSuccess) fprintf(stderr, "kernel_launch: launch failed: %s\n", hipGetErrorName(le));
}
```
